# Optimizing an MI355X kernel written in HIP

```python
import math
import jax, jax.numpy as jnp
from jax import lax
import numpy as np

D_MODEL = 1024
BATCH = 8
SEQ = 4096
DEPTH = 2

HEAD_DIM = 64
A_WIDTH = D_MODEL // 2
A_HEADS = A_WIDTH // HEAD_DIM
B_WIDTH = D_MODEL - A_WIDTH
DECAY_RANK = 64
ICL_RANK = 64
GATE_RANK = 128
CONV_WIDTH = 31
GN_EPS = 64e-5
A_PROJ = 3 * A_WIDTH + DECAY_RANK + ICL_RANK + GATE_RANK
EVEN_IN = A_PROJ + 2 * B_WIDTH
C_HEADS = D_MODEL // (2 * HEAD_DIM)
ODD_IN = 3 * D_MODEL
Q_BLOCK = 128
ROPE_THETA = 10000.0
ATTN_SCALE = HEAD_DIM ** -0.5
D_FF = 2816
N_EVEN = (DEPTH + 1) // 2
N_ODD = DEPTH // 2

kernel_name = "hybrid_rwkv7_conformer_diffattn_macaron"


def rmsnorm(x, g, eps=1e-6):
    xf = x.astype(jnp.float32)
    y = xf * lax.rsqrt(jnp.mean(xf * xf, axis=-1, keepdims=True) + eps)
    return (y * g.astype(jnp.float32)).astype(x.dtype)


def layernorm(x, g, b, eps=1e-5):
    xf = x.astype(jnp.float32)
    mu = jnp.mean(xf, axis=-1, keepdims=True)
    var = jnp.mean(jnp.square(xf - mu), axis=-1, keepdims=True)
    y = (xf - mu) * lax.rsqrt(var + eps)
    return (y * g.astype(jnp.float32) + b.astype(jnp.float32)).astype(x.dtype)


def swiglu(h, w_gate, w_up, w_down):
    return (jax.nn.silu(h @ w_gate) * (h @ w_up)) @ w_down


def token_shift(z):
    return jnp.pad(z, ((0, 0), (1, 0), (0, 0)))[:, :-1]


def rope_tables(seq):
    inv = 1.0 / (ROPE_THETA ** (jnp.arange(0, HEAD_DIM, 2, dtype=jnp.float32) / HEAD_DIM))
    ang = jnp.arange(seq, dtype=jnp.float32)[:, None] * inv[None, :]
    return jnp.cos(ang), jnp.sin(ang)


def apply_rope(x, cos, sin):
    xf = x.astype(jnp.float32)
    c = cos[None, :, None, None, :]
    s = sin[None, :, None, None, :]
    x1, x2 = xf[..., : HEAD_DIM // 2], xf[..., HEAD_DIM // 2:]
    return jnp.concatenate([x1 * c - x2 * s, x2 * c + x1 * s], axis=-1)


def wkv7_scan(r, w, k, v, a, b):
    Bsz, _, H, N = r.shape
    xs = tuple(jnp.moveaxis(t, 1, 0) for t in (r, w, k, v, a, b))

    def step(state, inp):
        r_t, w_t, k_t, v_t, a_t, b_t = inp
        sa = jnp.einsum('bhvk,bhk->bhv', state, a_t)
        state = (state * w_t[:, :, None, :]
                 + sa[..., None] * b_t[:, :, None, :]
                 + v_t[..., None] * k_t[:, :, None, :])
        y = jnp.einsum('bhvk,bhk->bhv', state, r_t)
        return state, y

    s0 = jnp.zeros((Bsz, H, N, N), jnp.float32)
    _, ys = lax.scan(step, s0, xs)
    return jnp.moveaxis(ys, 0, 1)


def rwkv_conv_mixer(h, w_in, mu, w0, w2, a0, a2, g2, k_k, k_a, r_k, ln_w, ln_b,
                    glu_bias, dw, dw_bias, cln_w, cln_b, w_out):
    Bsz, S, _ = h.shape
    f32 = jnp.float32
    z = h @ w_in
    za = z[..., :A_PROJ]
    za = za + (token_shift(za) - za) * mu
    cuts = [A_WIDTH, 2 * A_WIDTH, 3 * A_WIDTH, 3 * A_WIDTH + DECAY_RANK,
            3 * A_WIDTH + DECAY_RANK + ICL_RANK]
    r, k, v, wd, ad, gd = jnp.split(za, cuts, axis=-1)
    w_log = -jax.nn.softplus(-(w0 + jnp.tanh(wd) @ w2)) - 0.5
    decay = jnp.exp(-jnp.exp(w_log.astype(f32)))
    a = jax.nn.sigmoid(a0 + ad @ a2)
    g = jax.nn.sigmoid(gd) @ g2

    def heads(t):
        return t.reshape(Bsz, S, A_HEADS, HEAD_DIM).astype(f32)

    kk = heads(k * k_k)
    kk = kk / jnp.maximum(jnp.sqrt(jnp.sum(kk * kk, axis=-1, keepdims=True)), 1e-12)
    k = k * (1.0 + (a - 1.0) * k_a)
    rh, kh, vh, ah, wh = heads(r), heads(k), heads(v), heads(a), heads(decay)
    y = wkv7_scan(rh, wh, kh, vh, -kk, kk * ah)
    mean = jnp.mean(y, axis=-1, keepdims=True)
    var = jnp.mean(jnp.square(y - mean), axis=-1, keepdims=True)
    y = ((y - mean) * lax.rsqrt(var + GN_EPS)).reshape(Bsz, S, A_WIDTH)
    y = y * ln_w.astype(f32) + ln_b.astype(f32)
    bonus = (jnp.sum(rh * kh * r_k.astype(f32), axis=-1, keepdims=True) * vh).reshape(Bsz, S, A_WIDTH)
    y_a = ((y + bonus) * g.astype(f32)).astype(h.dtype)
    u = z[..., A_PROJ:] + glu_bias
    gl = u[..., :B_WIDTH] * jax.nn.sigmoid(u[..., B_WIDTH:])
    c = lax.conv_general_dilated(gl, dw[:, None, :], window_strides=(1,),
                                 padding=[(CONV_WIDTH - 1, 0)],
                                 dimension_numbers=('NWC', 'WIO', 'NWC'),
                                 feature_group_count=B_WIDTH) + dw_bias
    y_b = jax.nn.silu(layernorm(c, cln_w, cln_b))
    return jnp.concatenate([y_a, y_b], axis=-1) @ w_out


def diff_attention(h, w_in, q_norm, k_norm, lq1, lk1, lq2, lk2, sub_norm, w_out,
                   lam_init, cos, sin):
    Bsz, S, _ = h.shape
    f32 = jnp.float32
    z = h @ w_in
    q = z[..., :D_MODEL].reshape(Bsz, S, C_HEADS, 2, HEAD_DIM)
    k = z[..., D_MODEL:2 * D_MODEL].reshape(Bsz, S, C_HEADS, 2, HEAD_DIM)
    v = z[..., 2 * D_MODEL:].reshape(Bsz, S, C_HEADS, 2 * HEAD_DIM)
    q = apply_rope(rmsnorm(q, q_norm), cos, sin).transpose(3, 0, 2, 1, 4)
    k = apply_rope(rmsnorm(k, k_norm), cos, sin).transpose(3, 0, 2, 1, 4)
    vf = v.transpose(0, 2, 1, 3).astype(f32)
    lam = (jnp.exp(jnp.sum(lq1.astype(f32) * lk1.astype(f32)))
           - jnp.exp(jnp.sum(lq2.astype(f32) * lk2.astype(f32))) + lam_init)
    nb = S // Q_BLOCK
    qb = q.reshape(2, Bsz, C_HEADS, nb, Q_BLOCK, HEAD_DIM).transpose(3, 0, 1, 2, 4, 5)
    kpos = jnp.arange(S)

    def block(args):
        qi, i = args
        s = jnp.einsum('cbhqd,cbhkd->cbhqk', qi, k) * ATTN_SCALE
        qpos = i * Q_BLOCK + jnp.arange(Q_BLOCK)
        mask = kpos[None, :] <= qpos[:, None]
        p = jax.nn.softmax(jnp.where(mask, s, -jnp.inf), axis=-1)
        attn = p[0] - lam * p[1]
        return jnp.einsum('bhqk,bhkv->bhqv', attn, vf)

    o = lax.map(block, (qb, jnp.arange(nb)))
    o = o.transpose(1, 0, 3, 2, 4).reshape(Bsz, S, C_HEADS, 2 * HEAD_DIM)
    o = rmsnorm(o, sub_norm, eps=1e-5) * (1.0 - lam_init)
    return o.reshape(Bsz, S, D_MODEL).astype(h.dtype) @ w_out


def setup_inputs(seed: int = 0) -> dict:
    key = jax.random.key(seed)
    ks = iter(jax.random.split(key, 40))
    f32 = jnp.float32

    def nrm(shape, scale):
        return jax.random.normal(next(ks), shape, f32) * scale

    def gain(shape):
        return 1.0 + nrm(shape, 0.02)

    return {
        "x": nrm((BATCH, SEQ, D_MODEL), 1.0),
        "ffn_norm": gain((DEPTH, 2, D_MODEL)),
        "ffn_w_gate": nrm((DEPTH, 2, D_MODEL, D_FF), D_MODEL ** -0.5),
        "ffn_w_up": nrm((DEPTH, 2, D_MODEL, D_FF), D_MODEL ** -0.5),
        "ffn_w_down": nrm((DEPTH, 2, D_FF, D_MODEL), D_FF ** -0.5),
        "mix_norm": gain((DEPTH, D_MODEL)),
        "a_w_in": nrm((N_EVEN, D_MODEL, EVEN_IN), D_MODEL ** -0.5),
        "a_mu": jax.random.uniform(next(ks), (N_EVEN, A_PROJ), f32, 0.0, 1.0),
        "a_w0": jax.random.uniform(next(ks), (N_EVEN, A_WIDTH), f32, -3.0, 1.0),
        "a_w2": nrm((N_EVEN, DECAY_RANK, A_WIDTH), DECAY_RANK ** -0.5),
        "a_a0": nrm((N_EVEN, A_WIDTH), 0.1),
        "a_a2": nrm((N_EVEN, ICL_RANK, A_WIDTH), ICL_RANK ** -0.5),
        "a_g2": nrm((N_EVEN, GATE_RANK, A_WIDTH), GATE_RANK ** -0.5),
        "a_k_k": 0.85 + nrm((N_EVEN, A_WIDTH), 0.05),
        "a_k_a": 1.0 + nrm((N_EVEN, A_WIDTH), 0.05),
        "a_r_k": nrm((N_EVEN, A_HEADS, HEAD_DIM), 0.1),
        "a_ln_w": gain((N_EVEN, A_WIDTH)),
        "a_ln_b": nrm((N_EVEN, A_WIDTH), 0.02),
        "b_glu_bias": nrm((N_EVEN, 2 * B_WIDTH), 0.02),
        "b_dw": nrm((N_EVEN, CONV_WIDTH, B_WIDTH), CONV_WIDTH ** -0.5),
        "b_dw_bias": nrm((N_EVEN, B_WIDTH), 0.02),
        "b_ln_w": gain((N_EVEN, B_WIDTH)),
        "b_ln_b": nrm((N_EVEN, B_WIDTH), 0.02),
        "e_w_out": nrm((N_EVEN, D_MODEL, D_MODEL), D_MODEL ** -0.5),
        "c_w_in": nrm((N_ODD, D_MODEL, ODD_IN), D_MODEL ** -0.5),
        "c_q_norm": gain((N_ODD, HEAD_DIM)),
        "c_k_norm": gain((N_ODD, HEAD_DIM)),
        "c_lq1": nrm((N_ODD, HEAD_DIM), 0.1),
        "c_lk1": nrm((N_ODD, HEAD_DIM), 0.1),
        "c_lq2": nrm((N_ODD, HEAD_DIM), 0.1),
        "c_lk2": nrm((N_ODD, HEAD_DIM), 0.1),
        "c_sub_norm": gain((N_ODD, 2 * HEAD_DIM)),
        "c_w_out": nrm((N_ODD, D_MODEL, D_MODEL), D_MODEL ** -0.5),
    }


def reference(x, ffn_norm, ffn_w_gate, ffn_w_up, ffn_w_down, mix_norm,
              a_w_in, a_mu, a_w0, a_w2, a_a0, a_a2, a_g2, a_k_k, a_k_a, a_r_k,
              a_ln_w, a_ln_b, b_glu_bias, b_dw, b_dw_bias, b_ln_w, b_ln_b, e_w_out,
              c_w_in, c_q_norm, c_k_norm, c_lq1, c_lk1, c_lq2, c_lk2, c_sub_norm,
              c_w_out):
    cos, sin = rope_tables(x.shape[1])
    for layer in range(DEPTH):
        x = x + 0.5 * swiglu(rmsnorm(x, ffn_norm[layer, 0]), ffn_w_gate[layer, 0],
                             ffn_w_up[layer, 0], ffn_w_down[layer, 0])
        h = rmsnorm(x, mix_norm[layer])
        j = layer // 2
        if layer % 2 == 0:
            x = x + rwkv_conv_mixer(h, a_w_in[j], a_mu[j], a_w0[j], a_w2[j], a_a0[j],
                                    a_a2[j], a_g2[j], a_k_k[j], a_k_a[j], a_r_k[j],
                                    a_ln_w[j], a_ln_b[j], b_glu_bias[j], b_dw[j],
                                    b_dw_bias[j], b_ln_w[j], b_ln_b[j], e_w_out[j])
        else:
            lam_init = 0.8 - 0.6 * math.exp(-0.3 * layer)
            x = x + diff_attention(h, c_w_in[j], c_q_norm[j], c_k_norm[j], c_lq1[j],
                                   c_lk1[j], c_lq2[j], c_lk2[j], c_sub_norm[j],
                                   c_w_out[j], lam_init, cos, sin)
        x = x + 0.5 * swiglu(rmsnorm(x, ffn_norm[layer, 1]), ffn_w_gate[layer, 1],
                             ffn_w_up[layer, 1], ffn_w_down[layer, 1])
    return x
```

```cpp
#include <hip/hip_runtime.h>
#include <hip/hip_cooperative_groups.h>
#include <cstdio>
#include <cstdint>
#include <cmath>
namespace cg = cooperative_groups;
namespace pg8 {
#define PG8_LAS __attribute__((address_space(3)))
typedef unsigned short bf16_t;
typedef short bf16x8 __attribute__((ext_vector_type(8)));
typedef float f32x4 __attribute__((ext_vector_type(4)));
typedef unsigned u32x4 __attribute__((ext_vector_type(4)));
constexpr int BM = 256, BK = 64, HALF = 128, HTB = HALF * BK * 2  , STAGE_BYTES = 8 * HTB, NXCD = 8, WGM = 8;

__host__ __device__ __forceinline__ int lds_byte(int r, int c) { const int st = (r >> 4) * 2 + (c >> 5), rr = r & 15, cc = c & 31, ob = rr * 64 + cc * 2; return st * 1024 + (ob ^ (((ob >> 9) & 1) << 5)); }
__host__ __device__ __forceinline__ void stage_rc(int b, int& R, int& C) { const int st = b / 1024, sb = b % 1024, swz = sb ^ (((sb >> 9) & 1) << 5); R = (st >> 1) * 16 + swz / 64; C = (st & 1) * 32 + (swz % 64) / 2; }
__host__ __device__ __forceinline__ int perm32(int rho) { const int n = rho >> 4, i = rho & 15; return 8 * (i >> 2) + 4 * n + (i & 3); }

struct Unit { int pm, pn; };
struct Gemm { const bf16_t* A; const bf16_t* Bt; int M, N, K; };

struct StaticOrder {
    int nM, nN, nwg, G, c;
    __host__ __device__ void init(int M, int N, int G_, int c_) { nM = M / BM; nN = N / BM; nwg = nM * nN; G = G_; c = c_; }
    __host__ __device__ bool next(int i, Unit& u) const {
        const long L = (long)i * G + c; if (L >= nwg) return false;
        int wgid = (int)L; { const int q = nwg / NXCD, r = nwg % NXCD, xcd = wgid % NXCD, off = wgid / NXCD; wgid = (xcd < r ? xcd * (q + 1) : r * (q + 1) + (xcd - r) * q) + off; }
        const int nig = WGM * nN, gid = wgid / nig, fm = gid * WGM, gsz = (nM - fm) < WGM ? (nM - fm) : WGM;
        u.pm = fm + ((wgid % nig) % gsz); u.pn = (wgid % nig) / gsz; return true;
    }
    __device__ __forceinline__ void a_ready(const Unit&) const {}
    __device__ __forceinline__ void done(const Unit&) const {}
};

__device__ __forceinline__ unsigned cvt_pk_bf16(float lo, float hi) { unsigned r; asm volatile("v_cvt_pk_bf16_f32 %0, %1, %2" : "=v"(r) : "v"(lo), "v"(hi)); return r; }
typedef float f32x2 __attribute__((ext_vector_type(2)));
__device__ __forceinline__ f32x2 gelu_pk(f32x2 v) {
    const f32x2 av = __builtin_elementwise_abs(v), d = av * 0.2316418882f + 1.0f;
    f32x2 t; t.x = __builtin_amdgcn_rcpf(d.x); t.y = __builtin_amdgcn_rcpf(d.y);
    f32x2 q = t * 0.5307027145f + (-0.7265760135f); q = q * t + 0.7107068705f; q = q * t + (-0.142248368f); q = q * t + 0.127414796f; q = q * t;
    const f32x2 s = (v * v) * (-0.72134752044f);
    f32x2 e; e.x = __builtin_amdgcn_exp2f(s.x); e.y = __builtin_amdgcn_exp2f(s.y);
    const f32x2 m = v * (q * e), r = v - m;
    f32x2 o; o.x = v.x < 0.f ? m.x : r.x; o.y = v.y < 0.f ? m.y : r.y; return o;
}

template <int ACT  > struct EpiBf16 {
    static constexpr bool PERM = true, AFTER_DRAIN = false; static_assert(ACT == 0 || ACT == 1, "EpiBf16: ACT is 0 (none) or 1 (gelu_pk)");
    bf16_t* O; int ldc; const float* bias; int split_cols; size_t split_stride; float scale0;
    __device__ __forceinline__ void operator()(const f32x4 (&acc)[2][2][4][2], const Unit& u, int wr, int wc, int fr, int fq) const {
        const int row0 = u.pm * BM + wr * 64 + fr; int colt = u.pn * BM; bf16_t* base = O;
        float sc = 1.f; if (split_cols) { const int t = colt / split_cols; base += (size_t)t * split_stride; colt -= t * split_cols; if (t == 0) sc = scale0; }
        const int col0 = colt + wc * 32 + 8 * fq, bcol0 = u.pn * BM + wc * 32 + 8 * fq;
        f32x4 bv[2][2];
#pragma unroll
        for (int bj = 0; bj < 2; ++bj)
#pragma unroll
            for (int n = 0; n < 2; ++n) bv[bj][n] = bias ? *(const f32x4*)(bias + bcol0 + bj * HALF + 4 * n) : (f32x4){0.f, 0.f, 0.f, 0.f};
#pragma unroll
        for (int ai = 0; ai < 2; ++ai)
#pragma unroll
            for (int m = 0; m < 4; ++m) { bf16_t* rowp = base + (size_t)(row0 + ai * HALF + m * 16) * ldc + col0;
#pragma unroll
                for (int bj = 0; bj < 2; ++bj) { f32x4 v0 = acc[ai][bj][m][0] + bv[bj][0], v1 = acc[ai][bj][m][1] + bv[bj][1];
                    if (ACT == 1) { f32x2 a = gelu_pk((f32x2){v0[0], v0[1]}), b = gelu_pk((f32x2){v0[2], v0[3]}), c = gelu_pk((f32x2){v1[0], v1[1]}), d = gelu_pk((f32x2){v1[2], v1[3]});
                        v0 = (f32x4){a.x, a.y, b.x, b.y}; v1 = (f32x4){c.x, c.y, d.x, d.y}; }
                    v0 = v0 * sc; v1 = v1 * sc; u32x4 w; w.x = cvt_pk_bf16(v0[0], v0[1]); w.y = cvt_pk_bf16(v0[2], v0[3]); w.z = cvt_pk_bf16(v1[0], v1[1]); w.w = cvt_pk_bf16(v1[2], v1[3]);
                    *(u32x4*)(rowp + bj * HALF) = w; } }
    }
};
template <class Epi, class Sched, bool ALIGN_EPI = false, bool SP2 = false>
__device__ __forceinline__ void gemm_phase(PG8_LAS unsigned char* lds, const Gemm g, const Sched& S, const Epi& E) {
    int oz_; asm volatile("s_mov_b32 %0, 0" : "=s"(oz_));
    const int tid = threadIdx.x + oz_, wid = __builtin_amdgcn_readfirstlane(tid >> 6), lane = tid & 63, wr = wid >> 2, wc = wid & 3, fr = lane & 15, fq = lane >> 4;
    const int K = g.K, nt = K / BK;
    unsigned voffA[2], voffB[2];
#pragma unroll
    for (int i = 0; i < 2; ++i) { int R, C; stage_rc(tid * 16 + i * 8192, R, C); const int Rb = Epi::PERM ? ((R & ~31) + perm32(R & 31)) : R;
        voffA[i] = (unsigned)(R * K + C) * 2u; voffB[i] = (unsigned)(Rb * K + C) * 2u; }
    const size_t kstep = (size_t)(BK * 2);
    const size_t hstep = (size_t)HALF * K * 2;
    const size_t tstep = 2 * hstep;
    const unsigned ldsw = (unsigned)wid * 1024u;
    const int aoff = lds_byte(wr * 64 + fr, fq * 8), boff = lds_byte(wc * 32 + fr, fq * 8);
#define PG8_SA(b, h) (((b) * 2 + (h)) * HTB)
#define PG8_SB(b, h) ((4 + (b) * 2 + (h)) * HTB)
#define PG8_STAGE(bufoff, gbase, voff) do { _Pragma("unroll") for (int _i = 0; _i < 2; ++_i) \
        __builtin_amdgcn_global_load_lds((const unsigned*)((const char*)(gbase) + (voff)[_i]), (PG8_LAS unsigned*)(lds + (bufoff) + ldsw + _i * 8192), 16, 0, 0); } while (0)
#define PG8_LDA(dst, b, h) do { _Pragma("unroll") for (int m = 0; m < 4; ++m) _Pragma("unroll") for (int k = 0; k < 2; ++k) dst[m][k] = *(const PG8_LAS bf16x8*)(lds + PG8_SA(b, h) + aoff + m * 2048 + k * 1024); } while (0)
#define PG8_LDB(dst, b, h) do { _Pragma("unroll") for (int n = 0; n < 2; ++n) _Pragma("unroll") for (int k = 0; k < 2; ++k) dst[n][k] = *(const PG8_LAS bf16x8*)(lds + PG8_SB(b, h) + boff + n * 2048 + k * 1024); } while (0)
#define PG8_MMA(ai, bj, At, Bt) do { __builtin_amdgcn_s_setprio(1); _Pragma("unroll") for (int m = 0; m < 4; ++m) _Pragma("unroll") for (int n = 0; n < 2; ++n) _Pragma("unroll") for (int k = 0; k < 2; ++k) \
        acc[ai][bj][m][n] = __builtin_amdgcn_mfma_f32_16x16x32_bf16(Bt[n][k], At[m][k], acc[ai][bj][m][n], 0, 0, 0); __builtin_amdgcn_s_setprio(0); } while (0)
#define PG8_WAIT_V(n) asm volatile("s_waitcnt vmcnt(" #n ")" ::: "memory")
#define PG8_WAIT_L(n) asm volatile("s_waitcnt lgkmcnt(" #n ")" ::: "memory")
#define PG8_BAR __builtin_amdgcn_s_barrier()
#define PG8_SCHED __builtin_amdgcn_sched_barrier(0)
    Unit cur, nxt; int ui = 0;
    if (!S.next(0, cur)) return;
    f32x4 acc[2][2][4][2];
#pragma unroll
    for (int a = 0; a < 2; ++a)
#pragma unroll
        for (int b = 0; b < 2; ++b)
#pragma unroll
            for (int m = 0; m < 4; ++m)
#pragma unroll
                for (int n = 0; n < 2; ++n) acc[a][b][m][n] = (f32x4){0.f, 0.f, 0.f, 0.f};
    bf16x8 At[4][2], B0[2][2], B1[2][2];
    const char* cA = (const char*)g.A + (size_t)cur.pm * tstep; const char* cB = (const char*)g.Bt + (size_t)cur.pn * tstep;
    S.a_ready(cur);
    if constexpr (SP2) {
        PG8_STAGE(PG8_SB(0, 0), cB, voffB); PG8_STAGE(PG8_SB(0, 1), cB + hstep, voffB); PG8_STAGE(PG8_SA(0, 0), cA, voffA); PG8_STAGE(PG8_SA(0, 1), cA + hstep, voffA);
        if (wr == 1) PG8_BAR;
        PG8_WAIT_V(2); PG8_BAR;
        PG8_STAGE(PG8_SB(1, 0), cB + kstep, voffB); PG8_STAGE(PG8_SA(1, 0), cA + kstep, voffA); PG8_STAGE(PG8_SB(1, 1), cB + hstep + kstep, voffB);
        PG8_WAIT_V(6); PG8_BAR;
    } else {
        PG8_STAGE(PG8_SB(0, 0), cB, voffB); PG8_STAGE(PG8_SA(0, 0), cA, voffA); PG8_STAGE(PG8_SB(0, 1), cB + hstep, voffB); PG8_STAGE(PG8_SA(0, 1), cA + hstep, voffA);
        if (wr == 1) PG8_BAR;
        PG8_WAIT_V(4); PG8_BAR;
        PG8_STAGE(PG8_SB(1, 0), cB + kstep, voffB); PG8_STAGE(PG8_SA(1, 0), cA + kstep, voffA); PG8_STAGE(PG8_SB(1, 1), cB + hstep + kstep, voffB);
        PG8_WAIT_V(6); PG8_BAR;
    }
    for (;;) {
        const bool has_next = S.next(ui + 1, nxt);
        const char* nA = has_next ? (const char*)g.A + (size_t)nxt.pm * tstep : cA; const char* nB = has_next ? (const char*)g.Bt + (size_t)nxt.pn * tstep : cB;
        for (int t = 0; t < nt; t += 2) {
            const bool last = (t == nt - 2);
            const char* a1 = cA + (size_t)(t + 1) * kstep;
            const char* a2 = last ? nA : cA + (size_t)(t + 2) * kstep; const char* b2 = last ? nB : cB + (size_t)(t + 2) * kstep;
            const char* a3 = a2 + kstep; const char* b3 = b2 + kstep;
            if (last && has_next) S.a_ready(nxt);
            if constexpr (SP2) {
            PG8_LDB(B0, 0, 0); PG8_LDB(B1, 0, 1); PG8_SCHED; PG8_LDA(At, 0, 0); PG8_STAGE(PG8_SA(1, 1), a1 + hstep, voffA);
            PG8_WAIT_V(8); PG8_WAIT_L(0); PG8_BAR; PG8_MMA(0, 0, At, B0); PG8_MMA(0, 1, At, B1); PG8_BAR; PG8_SCHED;
            PG8_LDA(At, 0, 1); PG8_STAGE(PG8_SB(0, 0), b2, voffB); PG8_STAGE(PG8_SB(0, 1), b2 + hstep, voffB); PG8_STAGE(PG8_SA(0, 0), a2, voffA);
            PG8_WAIT_V(8); PG8_WAIT_L(0); PG8_BAR; PG8_MMA(1, 0, At, B0); PG8_MMA(1, 1, At, B1); PG8_BAR; PG8_SCHED;
            PG8_LDB(B0, 1, 0); PG8_LDB(B1, 1, 1); PG8_SCHED; PG8_LDA(At, 1, 0); PG8_STAGE(PG8_SA(0, 1), a2 + hstep, voffA);
            PG8_WAIT_V(8); PG8_WAIT_L(0); PG8_BAR; PG8_MMA(0, 0, At, B0); PG8_MMA(0, 1, At, B1); PG8_BAR; PG8_SCHED;
            PG8_LDA(At, 1, 1); PG8_STAGE(PG8_SB(1, 0), b3, voffB); PG8_STAGE(PG8_SB(1, 1), b3 + hstep, voffB); PG8_STAGE(PG8_SA(1, 0), a3, voffA);
            PG8_WAIT_V(8); PG8_WAIT_L(0); PG8_BAR; PG8_MMA(1, 0, At, B0); PG8_MMA(1, 1, At, B1); PG8_BAR; PG8_SCHED;
            } else {
            PG8_LDB(B0, 0, 0); PG8_SCHED; PG8_LDA(At, 0, 0); PG8_STAGE(PG8_SA(1, 1), a1 + hstep, voffA);
            PG8_WAIT_L(8); PG8_BAR; PG8_WAIT_L(0); PG8_MMA(0, 0, At, B0); PG8_BAR; PG8_SCHED;
            PG8_LDB(B1, 0, 1); PG8_STAGE(PG8_SB(0, 0), b2, voffB);
            PG8_BAR; PG8_WAIT_L(0); PG8_MMA(0, 1, At, B1); PG8_BAR;
            PG8_LDA(At, 0, 1); PG8_STAGE(PG8_SA(0, 0), a2, voffA);
            PG8_BAR; PG8_WAIT_L(0); PG8_MMA(1, 0, At, B0); PG8_BAR; PG8_SCHED;
            PG8_STAGE(PG8_SB(0, 1), b2 + hstep, voffB);
            PG8_WAIT_V(6); PG8_BAR; PG8_MMA(1, 1, At, B1); PG8_BAR;
            PG8_LDB(B0, 1, 0); PG8_SCHED; PG8_LDA(At, 1, 0); PG8_STAGE(PG8_SA(0, 1), a2 + hstep, voffA);
            PG8_WAIT_L(8); PG8_BAR; PG8_WAIT_L(0); PG8_MMA(0, 0, At, B0); PG8_BAR; PG8_SCHED;
            PG8_LDB(B1, 1, 1); PG8_STAGE(PG8_SB(1, 0), b3, voffB);
            PG8_BAR; PG8_WAIT_L(0); PG8_MMA(0, 1, At, B1); PG8_BAR;
            PG8_LDA(At, 1, 1); PG8_STAGE(PG8_SA(1, 0), a3, voffA);
            PG8_BAR; PG8_WAIT_L(0); PG8_MMA(1, 0, At, B0); PG8_BAR; PG8_SCHED;
            PG8_STAGE(PG8_SB(1, 1), b3 + hstep, voffB);
            PG8_WAIT_V(6); PG8_BAR; PG8_MMA(1, 1, At, B1); PG8_BAR;
            }
        }
        if constexpr (ALIGN_EPI) { if (wr == 0) PG8_BAR; }
        if constexpr (!Epi::AFTER_DRAIN) { E(acc, cur, wr, wc, fr, fq); S.done(cur); }
        if (!has_next) break;
#pragma unroll
        for (int a = 0; a < 2; ++a)
#pragma unroll
            for (int b = 0; b < 2; ++b)
#pragma unroll
                for (int m = 0; m < 4; ++m)
#pragma unroll
                    for (int n = 0; n < 2; ++n) acc[a][b][m][n] = (f32x4){0.f, 0.f, 0.f, 0.f};
        cur = nxt; cA = nA; cB = nB; ++ui;
        if constexpr (ALIGN_EPI) { if (wr == 1) PG8_BAR; }
    }
    PG8_WAIT_V(0);
    if constexpr (!ALIGN_EPI) { if (wr == 0) PG8_BAR; }
    PG8_BAR;
    if constexpr (Epi::AFTER_DRAIN) { E.fused(acc, cur, wr, wc, fr, fq, lds, wid, lane); S.done(cur); }
#undef PG8_SA
#undef PG8_SB
#undef PG8_STAGE
#undef PG8_LDA
#undef PG8_LDB
#undef PG8_MMA
#undef PG8_WAIT_V
#undef PG8_WAIT_L
#undef PG8_BAR
#undef PG8_SCHED
}
}

#define LAS __attribute__((address_space(3)))
typedef unsigned short bf16;
typedef float f32x4 __attribute__((ext_vector_type(4)));
typedef float f32x2 __attribute__((ext_vector_type(2)));
typedef float f32x16 __attribute__((ext_vector_type(16)));
typedef short bf16x8 __attribute__((ext_vector_type(8)));
typedef unsigned u32x4 __attribute__((ext_vector_type(4)));
typedef unsigned u32x2 __attribute__((ext_vector_type(2)));
typedef __bf16 bf16x2_t __attribute__((ext_vector_type(2)));

constexpr int NWAVES = 8, NTHR = 512;
constexpr int BATCH = 8, SEQ = 4096, DM = 1024, T = BATCH * SEQ, DFF = 2816;
constexpr int ZW = 2816;
constexpr int Z3W = 3072;
constexpr int LDS_BYTES = 147456;
constexpr float LAM_INIT = 0.35550906759096934f;
constexpr float QSCALE = 0.125f * 1.4426950408889634f;

constexpr size_t MiB = 1u << 20;
constexpr size_t WS_WGU = 0;
constexpr size_t WGU_STRIDE = (size_t)5632 * 1024 * 2;
constexpr size_t WS_WD = 44 * MiB;
constexpr size_t WD_STRIDE = (size_t)1024 * 2816 * 2;
constexpr size_t WS_WAIN = 66 * MiB;
constexpr size_t WS_WEOUT = 72 * MiB;
constexpr size_t WS_WCIN = 74 * MiB;
constexpr size_t WS_WCOUT = 80 * MiB;
constexpr size_t WS_WBD = 82 * MiB;
constexpr size_t WS_ROPE = 83 * MiB;
constexpr size_t WS_BON = 84 * MiB;
constexpr size_t WS_LAM = 85 * MiB;
constexpr size_t WS_BAR = 85 * MiB + 65536;
constexpr size_t WS_RSQ = 86 * MiB;
constexpr size_t WS_XN = 88 * MiB;
constexpr size_t WS_BIG = 152 * MiB;
constexpr size_t WS_LRIN = 328 * MiB;
constexpr size_t WS_R1 = 344 * MiB;
constexpr size_t WS_R2 = 408 * MiB;
constexpr size_t WS_R3 = 440 * MiB;
constexpr size_t WS_R4 = 472 * MiB;
constexpr size_t WS_END = 504 * MiB;

__device__ const float ROPE_INV[32] = {
    1.000000000e+00f, 7.498942018e-01f, 5.623413324e-01f, 4.216965139e-01f, 3.162277639e-01f, 2.371373922e-01f, 1.778279394e-01f, 1.333521456e-01f,
    1.000000015e-01f, 7.498941571e-02f, 5.623412877e-02f, 4.216964915e-02f, 3.162277862e-02f, 2.371373586e-02f, 1.778279431e-02f, 1.333521493e-02f,
    9.999999776e-03f, 7.498942316e-03f, 5.623413250e-03f, 4.216964822e-03f, 3.162277862e-03f, 2.371373819e-03f, 1.778279431e-03f, 1.333521446e-03f,
    1.000000047e-03f, 7.498941850e-04f, 5.623413017e-04f, 4.216965463e-04f, 3.162277862e-04f, 2.371373848e-04f, 1.778279402e-04f, 1.333521504e-04f};

__device__ __forceinline__ unsigned pk2(float lo, float hi) { f32x2 v = {lo, hi}; bf16x2_t b = __builtin_convertvector(v, bf16x2_t); return __builtin_bit_cast(unsigned, b); }
__device__ __forceinline__ float bflo(unsigned u) { return __uint_as_float(u << 16); }
__device__ __forceinline__ float bfhi(unsigned u) { return __uint_as_float(u & 0xffff0000u); }
__device__ __forceinline__ f32x4 bf4(u32x2 u) { return (f32x4){bflo(u.x), bfhi(u.x), bflo(u.y), bfhi(u.y)}; }
__device__ __forceinline__ u32x2 pk4(f32x4 v) { u32x2 r; r.x = pk2(v.x, v.y); r.y = pk2(v.z, v.w); return r; }
__device__ __forceinline__ float fexp(float x) { return __builtin_amdgcn_exp2f(x * 1.4426950408889634f); }
__device__ __forceinline__ float fsigmoid(float x) { return __builtin_amdgcn_rcpf(1.0f + fexp(-x)); }
__device__ __forceinline__ float ftanh(float x) { return 1.0f - 2.0f * __builtin_amdgcn_rcpf(fexp(2.0f * x) + 1.0f); }
template <int CTRL> __device__ __forceinline__ float dppf(float v) { return __int_as_float(__builtin_amdgcn_update_dpp(0, __float_as_int(v), CTRL, 0xf, 0xf, true)); }
__device__ __forceinline__ float red8(float v) { v += dppf<0xB1>(v); v += dppf<0x4E>(v); v += dppf<0x141>(v); return v; }
__device__ __forceinline__ float red16(float v) { v = red8(v); v += dppf<0x140>(v); return v; }
__device__ __forceinline__ float wave_sum(float v) {
    v = red16(v);
    const int i = __float_as_int(v);
    const float a0 = __int_as_float(__builtin_amdgcn_readlane(i, 0)), a1 = __int_as_float(__builtin_amdgcn_readlane(i, 16)), a2 = __int_as_float(__builtin_amdgcn_readlane(i, 32)), a3 = __int_as_float(__builtin_amdgcn_readlane(i, 48));
    return (a0 + a1) + (a2 + a3);
}
__device__ __forceinline__ float xhalf_sum(float v);
__device__ __forceinline__ float fq_sum(float v) {
    v += __int_as_float(__builtin_amdgcn_ds_swizzle(__float_as_int(v), 0x401F));
    auto rr = __builtin_amdgcn_permlane32_swap(__float_as_uint(v), __float_as_uint(v), false, false); return __uint_as_float(rr[0]) + __uint_as_float(rr[1]);
}
__device__ __forceinline__ float max3f(float a, float b, float c) { float r; asm("v_max3_f32 %0, %1, %2, %3" : "=v"(r) : "v"(a), "v"(b), "v"(c)); return r; }
__device__ __forceinline__ float xhalf_max(float v) { auto rr = __builtin_amdgcn_permlane32_swap(__float_as_uint(v), __float_as_uint(v), false, false); return fmaxf(__uint_as_float(rr[0]), __uint_as_float(rr[1])); }
__device__ __forceinline__ float xhalf_sum(float v) { auto rr = __builtin_amdgcn_permlane32_swap(__float_as_uint(v), __float_as_uint(v), false, false); return __uint_as_float(rr[0]) + __uint_as_float(rr[1]); }

__device__ __forceinline__ void lds_barrier() { asm volatile("s_waitcnt lgkmcnt(0)" ::: "memory"); __builtin_amdgcn_s_barrier(); asm volatile("" ::: "memory"); }
__device__ __forceinline__ u32x4 gload16_asm(const void* p) { u32x4 r; asm volatile("global_load_dwordx4 %0, %1, off" : "=v"(r) : "v"(p) : "memory"); return r; }
struct Args { const float* in[33]; float* out; unsigned char* ws; int ph_lo, ph_hi; };

__device__ __forceinline__ void row_rstd8(const float* rsq, int row0, int fq, float (&rs)[8]) {
    if (!rsq) {
#pragma unroll
        for (int i = 0; i < 8; ++i) rs[i] = 1.f;
        return;
    }
    f32x4 p[8];
#pragma unroll
    for (int i = 0; i < 8; ++i) p[i] = *(const f32x4*)(rsq + (size_t)(row0 + (i >> 2) * 128 + (i & 3) * 16) * 16 + 4 * fq);
    asm volatile("" ::: "memory");
#pragma unroll
    for (int i = 0; i < 8; ++i) rs[i] = rsqrtf(fq_sum((p[i].x + p[i].y) + (p[i].z + p[i].w)) * (1.f / DM) + 1e-6f);
}
struct EpiSwiGLU {
    static constexpr bool PERM = true, AFTER_DRAIN = false;
    bf16* O;
    const float* rsq;
    __device__ __forceinline__ void operator()(const pg8::f32x4 (&acc)[2][2][4][2], const pg8::Unit& u, int wr, int wc, int fr, int fq) const {
        int oz; asm volatile("v_mov_b32 %0, 0" : "=v"(oz));
        const int row0 = u.pm * 256 + wr * 64 + fr + oz, col0 = u.pn * 128 + wc * 32 + 8 * fq;
        float rs8[8]; row_rstd8(rsq, row0, fq, rs8);
#pragma unroll
        for (int ai = 0; ai < 2; ++ai)
#pragma unroll
            for (int m = 0; m < 4; ++m) {
                bf16* p = O + (size_t)(row0 + ai * 128 + m * 16) * DFF + col0;
                const float r = rs8[ai * 4 + m];
                const f32x2 rr2 = {r * r, r * r}, nl2 = {-1.4426950408889634f * r, -1.4426950408889634f * r};
                unsigned w[4];
#pragma unroll
                for (int n = 0; n < 2; ++n)
#pragma unroll
                    for (int e = 0; e < 4; e += 2) {
                        const f32x2 ag = {acc[ai][0][m][n][e], acc[ai][0][m][n][e + 1]}, au = {acc[ai][1][m][n][e], acc[ai][1][m][n][e + 1]};
                        const f32x2 x = ag * nl2;
                        f32x2 d = {__builtin_amdgcn_exp2f(x.x), __builtin_amdgcn_exp2f(x.y)};
                        d = d + 1.0f;
                        const f32x2 rc = {__builtin_amdgcn_rcpf(d.x), __builtin_amdgcn_rcpf(d.y)};
                        const f32x2 hh = (ag * au) * (rc * rr2);
                        w[2 * n + (e >> 1)] = pk2(hh.x, hh.y);
                    }
                *(u32x4*)p = (u32x4){w[0], w[1], w[2], w[3]};
            }
    }
};
struct EpiResid {
    static constexpr bool PERM = false, AFTER_DRAIN = false;
    const float* base; float* out; const float* gn; bf16* XN; float* rsq; float scale, pad_;
    __device__ __forceinline__ void operator()(const pg8::f32x4 (&acc)[2][2][4][2], const pg8::Unit& u, int wr, int wc, int fr, int fq) const {
        int oz; asm volatile("v_mov_b32 %0, 0" : "=v"(oz));
        const int row0 = u.pm * 256 + wr * 64 + fr + oz, col0 = u.pn * 256 + wc * 32 + 4 * fq;
        const float* gp = gn ? gn : base;
        f32x4 g4[2][2];
#pragma unroll
        for (int bj = 0; bj < 2; ++bj)
#pragma unroll
            for (int n = 0; n < 2; ++n) g4[bj][n] = *(const f32x4*)(gp + col0 + bj * 128 + n * 16);
#pragma unroll
        for (int ai = 0; ai < 2; ++ai) {
            f32x4 bv[4][2][2];
#pragma unroll
            for (int m = 0; m < 4; ++m)
#pragma unroll
                for (int bj = 0; bj < 2; ++bj)
#pragma unroll
                    for (int n = 0; n < 2; ++n) bv[m][bj][n] = *(const f32x4*)(base + (size_t)(row0 + ai * 128 + m * 16) * DM + col0 + bj * 128 + n * 16);
            asm volatile("" ::: "memory");
#pragma unroll
            for (int m = 0; m < 4; ++m) {
                const int row = row0 + ai * 128 + m * 16;
                const size_t ro = (size_t)row * DM + col0;
                float ss = 0.f;
#pragma unroll
                for (int bj = 0; bj < 2; ++bj)
#pragma unroll
                    for (int n = 0; n < 2; ++n) {
                        const size_t off = ro + bj * 128 + n * 16;
                        f32x4 a; a.x = acc[ai][bj][m][n][0]; a.y = acc[ai][bj][m][n][1]; a.z = acc[ai][bj][m][n][2]; a.w = acc[ai][bj][m][n][3];
                        const f32x4 v = bv[m][bj][n] + a * scale;
                        *(f32x4*)(out + off) = v;
                        if (gn) { *(u32x2*)(XN + off) = pk4(v * g4[bj][n]); ss += (v.x * v.x + v.y * v.y) + (v.z * v.z + v.w * v.w); }
                    }
                if (gn) { ss = fq_sum(ss); if (fq == 0) rsq[(size_t)row * 16 + u.pn * 4 + wc] = ss; }
            }
        }
    }
};
struct EpiStore {
    static constexpr bool PERM = true, AFTER_DRAIN = false;
    bf16* O; int ldc; const float* rsq;
    __device__ __forceinline__ void operator()(const pg8::f32x4 (&acc)[2][2][4][2], const pg8::Unit& u, int wr, int wc, int fr, int fq) const {
        int oz; asm volatile("v_mov_b32 %0, 0" : "=v"(oz));
        const int row0 = u.pm * 256 + wr * 64 + fr + oz, col0 = u.pn * 256 + wc * 32 + 8 * fq;
        float rs8[8]; row_rstd8(rsq, row0, fq, rs8);
#pragma unroll
        for (int ai = 0; ai < 2; ++ai)
#pragma unroll
            for (int m = 0; m < 4; ++m) {
                bf16* p = O + (size_t)(row0 + ai * 128 + m * 16) * ldc + col0;
                const float r = rs8[ai * 4 + m];
#pragma unroll
                for (int bj = 0; bj < 2; ++bj) {
                    u32x4 w; w.x = pk2(acc[ai][bj][m][0][0] * r, acc[ai][bj][m][0][1] * r); w.y = pk2(acc[ai][bj][m][0][2] * r, acc[ai][bj][m][0][3] * r);
                    w.z = pk2(acc[ai][bj][m][1][0] * r, acc[ai][bj][m][1][1] * r); w.w = pk2(acc[ai][bj][m][1][2] * r, acc[ai][bj][m][1][3] * r);
                    *(u32x4*)(p + bj * 128) = w;
                }
            }
    }
};
__device__ __forceinline__ float decay_f(float x) {
    const float y = -x, sp = fmaxf(y, 0.f) + __builtin_amdgcn_logf(1.0f + fexp(-fabsf(y))) * 0.6931471805599453f;
    return fexp(-fexp(-sp - 0.5f));
}

struct EpiLowRank {
    static constexpr bool PERM = true, AFTER_DRAIN = false;
    float* W; bf16* Aa; bf16* G; const float* w0; const float* a0;
    __device__ __forceinline__ void operator()(const pg8::f32x4 (&acc)[2][2][4][2], const pg8::Unit& u, int wr, int wc, int fr, int fq) const {
        const int region = u.pn >> 1;
        int oz; asm volatile("v_mov_b32 %0, 0" : "=v"(oz));
        const int row0 = u.pm * 256 + wr * 64 + fr + oz, col0 = (u.pn & 1) * 256 + wc * 32 + 8 * fq;
        bf16* OB = region == 1 ? Aa : G;
        const float* bp = region == 0 ? w0 : a0;
#pragma unroll
        for (int bj = 0; bj < 2; ++bj) {
            f32x4 b0 = {0.f, 0.f, 0.f, 0.f}, b1 = b0;
            if (region < 2) { b0 = *(const f32x4*)(bp + col0 + bj * 128); b1 = *(const f32x4*)(bp + col0 + bj * 128 + 4); }
#pragma unroll
            for (int ai = 0; ai < 2; ++ai)
#pragma unroll
                for (int m = 0; m < 4; ++m) {
                    const size_t off = (size_t)(row0 + ai * 128 + m * 16) * 512 + col0 + bj * 128;
                    f32x4 v0 = (f32x4){acc[ai][bj][m][0][0], acc[ai][bj][m][0][1], acc[ai][bj][m][0][2], acc[ai][bj][m][0][3]} + b0;
                    f32x4 v1 = (f32x4){acc[ai][bj][m][1][0], acc[ai][bj][m][1][1], acc[ai][bj][m][1][2], acc[ai][bj][m][1][3]} + b1;
                    if (region == 0) {
                        *(f32x4*)(W + off) = (f32x4){decay_f(v0.x), decay_f(v0.y), decay_f(v0.z), decay_f(v0.w)};
                        *(f32x4*)(W + off + 4) = (f32x4){decay_f(v1.x), decay_f(v1.y), decay_f(v1.z), decay_f(v1.w)};
                    } else {
                        if (region == 1) { v0 = (f32x4){fsigmoid(v0.x), fsigmoid(v0.y), fsigmoid(v0.z), fsigmoid(v0.w)}; v1 = (f32x4){fsigmoid(v1.x), fsigmoid(v1.y), fsigmoid(v1.z), fsigmoid(v1.w)}; }
                        u32x4 w; w.x = pk2(v0.x, v0.y); w.y = pk2(v0.z, v0.w); w.z = pk2(v1.x, v1.y); w.w = pk2(v1.z, v1.w);
                        *(u32x4*)(OB + off) = w;
                    }
                    asm volatile("" ::: "memory");
                }
        }
    }
};

template <class Epi> __device__ __forceinline__ void run_gemm(LAS unsigned char* lds, const bf16* A, const bf16* Bt, int N, int K, const Epi& E) {
    asm volatile("" : "+s"(N), "+s"(K));
    pg8::Gemm g{A, Bt, T, N, K}; pg8::StaticOrder S; S.init(T, N, (int)gridDim.x, (int)blockIdx.x);
    pg8::gemm_phase<Epi, pg8::StaticOrder, true, true>(lds, g, S, E);
}

__device__ __forceinline__ void transpose_item(const float* W, int K, int N, bf16* WT, int mode, LAS float* scr, int item, int lane) {
    const int nblk = N / 32, kb = item / nblk, nb = item % nblk, k0 = 64 * kb, n0 = 32 * nb;
    int drow0 = n0; if (mode) drow0 = 256 * (n0 >> 7) + (n0 & 127) + (mode == 2 ? 128 : 0);
    float tv[32];
#pragma unroll
    for (int i = 0; i < 32; ++i) tv[i] = W[(size_t)(k0 + 2 * i + (lane >> 5)) * N + n0 + (lane & 31)];
#pragma unroll
    for (int i = 0; i < 32; ++i) scr[(2 * i + (lane >> 5)) * 33 + (lane & 31)] = tv[i];
    asm volatile("s_waitcnt lgkmcnt(0)" ::: "memory");
    const int c = lane & 7;
#pragma unroll
    for (int j = 0; j < 4; ++j) { const int n = (lane >> 3) + 8 * j; const LAS float* s = scr + (8 * c) * 33 + n;
        u32x4 o; o.x = pk2(s[0 * 33], s[1 * 33]); o.y = pk2(s[2 * 33], s[3 * 33]); o.z = pk2(s[4 * 33], s[5 * 33]); o.w = pk2(s[6 * 33], s[7 * 33]);
        *(u32x4*)(WT + (size_t)(drow0 + n) * K + k0 + 8 * c) = o; }
    asm volatile("s_waitcnt lgkmcnt(0)" ::: "memory");
}

__device__ __forceinline__ void transpose_load(const float* W, int K, int N, int item, int lane, float (&tv)[32]) {
    const int nblk = N / 32, kb = item / nblk, nb = item % nblk, k0 = 64 * kb, n0 = 32 * nb;
#pragma unroll
    for (int i = 0; i < 32; ++i) tv[i] = W[(size_t)(k0 + 2 * i + (lane >> 5)) * N + n0 + (lane & 31)];
}
__device__ __forceinline__ void transpose_store(int K, int N, bf16* WT, int mode, LAS float* scr, int item, int lane, const float (&tv)[32]) {
    const int nblk = N / 32, kb = item / nblk, nb = item % nblk, k0 = 64 * kb, n0 = 32 * nb;
    int drow0 = n0; if (mode) drow0 = 256 * (n0 >> 7) + (n0 & 127) + (mode == 2 ? 128 : 0);
#pragma unroll
    for (int i = 0; i < 32; ++i) scr[(2 * i + (lane >> 5)) * 33 + (lane & 31)] = tv[i];
    asm volatile("s_waitcnt lgkmcnt(0)" ::: "memory");
    const int c = lane & 7;
#pragma unroll
    for (int j = 0; j < 4; ++j) { const int n = (lane >> 3) + 8 * j; const LAS float* sp = scr + (8 * c) * 33 + n;
        u32x4 o; o.x = pk2(sp[0 * 33], sp[1 * 33]); o.y = pk2(sp[2 * 33], sp[3 * 33]); o.z = pk2(sp[4 * 33], sp[5 * 33]); o.w = pk2(sp[6 * 33], sp[7 * 33]);
        *(u32x4*)(WT + (size_t)(drow0 + n) * K + k0 + 8 * c) = o; }
    asm volatile("s_waitcnt lgkmcnt(0)" ::: "memory");
}
constexpr int DI_GU = 16 * 88, DI_D = 44 * 32, DI_SQ = 16 * 32, DI_CIN = 16 * 96;
constexpr int DEFER_ITEMS = 6 * DI_GU + 3 * DI_D + DI_SQ + DI_CIN + DI_SQ;
struct DeferItem { const float* W; bf16* WT; int K, N, mode, item; };
__device__ __forceinline__ DeferItem defer_decode(const Args& a, int it) {
    DeferItem d; unsigned char* ws = a.ws; int r = it;
    if (r < 6 * DI_GU) { const int f = 1 + r / (2 * DI_GU), which = (r / DI_GU) & 1;
        d.W = (which ? a.in[3] : a.in[2]) + (size_t)f * DM * DFF; d.WT = (bf16*)(ws + WS_WGU + f * WGU_STRIDE); d.K = DM; d.N = DFF; d.mode = 1 + which; d.item = r % DI_GU; return d; }
    r -= 6 * DI_GU;
    if (r < 3 * DI_D) { const int f = 1 + r / DI_D; d.W = a.in[4] + (size_t)f * DFF * DM; d.WT = (bf16*)(ws + WS_WD + f * WD_STRIDE); d.K = DFF; d.N = DM; d.mode = 0; d.item = r % DI_D; return d; }
    r -= 3 * DI_D;
    if (r < DI_SQ) { d.W = a.in[23]; d.WT = (bf16*)(ws + WS_WEOUT); d.K = DM; d.N = DM; d.mode = 0; d.item = r; return d; } r -= DI_SQ;
    if (r < DI_CIN) { d.W = a.in[24]; d.WT = (bf16*)(ws + WS_WCIN); d.K = DM; d.N = Z3W; d.mode = 0; d.item = r; return d; } r -= DI_CIN;
    d.W = a.in[32]; d.WT = (bf16*)(ws + WS_WCOUT); d.K = DM; d.N = DM; d.mode = 0; d.item = r; return d;
}

__device__ __forceinline__ void rmsnorm_phase(const float* X, const float* g, bf16* XN, int gw, int NGW, int lane) {
    f32x4 gv[4];
#pragma unroll
    for (int j = 0; j < 4; ++j) gv[j] = *(const f32x4*)(g + 4 * lane + 256 * j);
#pragma unroll 4
    for (int m = gw; m < T; m += NGW) {
        const f32x4* xr = (const f32x4*)(X + (size_t)m * DM) + lane;
        f32x4 v[4]; float s = 0.f;
#pragma unroll
        for (int j = 0; j < 4; ++j) { v[j] = xr[64 * j]; s += (v[j].x * v[j].x + v[j].y * v[j].y) + (v[j].z * v[j].z + v[j].w * v[j].w); }
        const float rstd = rsqrtf(wave_sum(s) * (1.f / DM) + 1e-6f);
        u32x2* o8 = (u32x2*)(XN + (size_t)m * DM) + lane;
#pragma unroll
        for (int j = 0; j < 4; ++j) o8[64 * j] = pk4(v[j] * rstd * gv[j]);
    }
}

__device__ __forceinline__ void prologue_phase(const Args& a, LAS unsigned char* lds, int tid, int lane, int wave) {
    unsigned char* ws = a.ws;
    LAS float* scr = (LAS float*)(lds + wave * 16384);
    const int gw = blockIdx.x * NWAVES + wave, NGW = gridDim.x * NWAVES;
    constexpr int I_GU = 16 * 88, I_D = 44 * 32, I_AIN = 16 * 88;
    constexpr int NITEMS = 2 * I_GU + I_D + I_AIN;
    for (int it = gw; it < NITEMS; it += NGW) {
        int r = it;
        if (r < 2 * I_GU) { const int which = r / I_GU, i = r % I_GU; transpose_item(which ? a.in[3] : a.in[2], DM, DFF, (bf16*)(ws + WS_WGU), 1 + which, scr, i, lane); continue; }
        r -= 2 * I_GU;
        if (r < I_D) { transpose_item(a.in[4], DFF, DM, (bf16*)(ws + WS_WD), 0, scr, r, lane); continue; }
        r -= I_D;
        transpose_item(a.in[6], DM, ZW, (bf16*)(ws + WS_WAIN), 0, scr, r, lane);
    }
    {
        bf16* BD = (bf16*)(ws + WS_WBD);
        const int gt = blockIdx.x * NTHR + tid, NGT = gridDim.x * NTHR;
        for (int i = gt; i < 1536 * 256; i += NGT) {
            const int n = i >> 8, k = i & 255; float v = 0.f;
            if (n < 512) { if (k < 64) v = a.in[9][k * 512 + n]; }
            else if (n < 1024) { if (k >= 64 && k < 128) v = a.in[11][(k - 64) * 512 + (n - 512)]; }
            else { if (k >= 128) v = a.in[12][(k - 128) * 512 + (n - 1024)]; }
            BD[i] = (bf16)(pk2(v, 0.f) & 0xffffu);
        }
        float* COS = (float*)(ws + WS_ROPE); float* SIN = COS + SEQ * 32;
        for (int i = gt; i < SEQ * 32; i += NGT) {
            const int s = i >> 5, j = i & 31;
            const float ang = (float)s * ROPE_INV[j];
            double rev = (double)ang * 0.15915494309189535; rev -= floor(rev);
            COS[i] = __builtin_amdgcn_cosf((float)rev); SIN[i] = __builtin_amdgcn_sinf((float)rev);
        }
        if (blockIdx.x == 0 && wave == 0) {
            const float s1 = wave_sum(a.in[27][lane] * a.in[28][lane]), s2 = wave_sum(a.in[29][lane] * a.in[30][lane]);
            if (lane == 0) *(float*)(ws + WS_LAM) = expf(s1) - expf(s2) + LAM_INIT;
        }
    }
    rmsnorm_phase(a.in[0], a.in[1], (bf16*)(ws + WS_XN), gw, NGW, lane);
}

__device__ __forceinline__ void e1_phase(const bf16* Z, const float* mu, bf16* LR, int tid) {
    const int seg = tid & 31, col = 1536 + 8 * seg;
    float muv[8];
#pragma unroll
    for (int e = 0; e < 8; ++e) muv[e] = mu[col + e];
#pragma unroll 2
    for (int it = blockIdx.x; it < T / 16; it += gridDim.x) {
        const int m = it * 16 + (tid >> 5), s = m & (SEQ - 1);
        const u32x4 zc = *(const u32x4*)(Z + (size_t)m * ZW + col);
        u32x4 zp = {0u, 0u, 0u, 0u}; if (s) zp = *(const u32x4*)(Z + (size_t)(m - 1) * ZW + col);
        float v[8];
#pragma unroll
        for (int e = 0; e < 4; ++e) { const float c0 = bflo(zc[e]), c1 = bfhi(zc[e]), p0 = bflo(zp[e]), p1 = bfhi(zp[e]);
            v[2 * e] = c0 + (p0 - c0) * muv[2 * e]; v[2 * e + 1] = c1 + (p1 - c1) * muv[2 * e + 1]; }
        if (seg < 8) {
#pragma unroll
            for (int e = 0; e < 8; ++e) v[e] = ftanh(v[e]);
        } else if (seg >= 16) {
#pragma unroll
            for (int e = 0; e < 8; ++e) v[e] = fsigmoid(v[e]);
        }
        u32x4 w; w.x = pk2(v[0], v[1]); w.y = pk2(v[2], v[3]); w.z = pk2(v[4], v[5]); w.w = pk2(v[6], v[7]);
        *(u32x4*)(LR + (size_t)m * 256 + 8 * seg) = w;
    }
}
__device__ __forceinline__ void e2_phase(const Args& a, const bf16* Z, bf16* Aa, float* W, bf16* KK, float* BON, int gw, int NGW, int lane) {
    const float* mu = a.in[7];
    const int half = gw & 1, c = half * 256 + 4 * lane, h = c >> 6;
    const f32x4 mur = *(const f32x4*)(mu + c), muk = *(const f32x4*)(mu + 512 + c), kkw = *(const f32x4*)(a.in[13] + c), kaw = *(const f32x4*)(a.in[14] + c), rkw = *(const f32x4*)(a.in[15] + c), a0w = *(const f32x4*)(a.in[10] + c), w0w = *(const f32x4*)(a.in[8] + c);
    const int MS = NGW >> 1;
    for (int mb = gw >> 1; mb < T; mb += 4 * MS) {
        u32x2 zr[4], zk[4], zrp[4], zkp[4], za[4];
#pragma unroll
        for (int i = 0; i < 4; ++i) {
            const int m = mb + i * MS; const bool ok = m < T; const int mm = ok ? m : 0, s = mm & (SEQ - 1);
            const bf16* zp = Z + (size_t)mm * ZW + c;
            zr[i] = *(const u32x2*)zp; zk[i] = *(const u32x2*)(zp + 512); za[i] = *(const u32x2*)(Aa + (size_t)mm * 512 + c);
            const bf16* zq = s ? zp - ZW : zp;
            zrp[i] = *(const u32x2*)zq; zkp[i] = *(const u32x2*)(zq + 512);
            if (!s) { zrp[i] = (u32x2){0u, 0u}; zkp[i] = zrp[i]; }
        }
#pragma unroll
        for (int i = 0; i < 4; ++i) {
            const int m = mb + i * MS; if (m >= T) break;
            const f32x4 rc = bf4(zr[i]), kc = bf4(zk[i]), rp = bf4(zrp[i]), kp = bf4(zkp[i]), av = bf4(za[i]);
            const f32x4 r = rc + (rp - rc) * mur, k = kc + (kp - kc) * muk;
            const f32x4 kr = k * kkw;
            const float ss = red16((kr.x * kr.x + kr.y * kr.y) + (kr.z * kr.z + kr.w * kr.w));
            const float inv = 1.0f / fmaxf(sqrtf(ss), 1e-12f);
            const f32x4 kt = k * (1.0f + (av - 1.0f) * kaw);
            const f32x4 bb = r * kt * rkw;
            const float bon = red16((bb.x + bb.y) + (bb.z + bb.w));
            *(u32x2*)(KK + (size_t)m * 512 + c) = pk4(kr * inv);
            if ((lane & 15) == 0) BON[m * 8 + h] = bon;
        }
    }
}

constexpr int SCH = 32, SROW = 336;
__device__ __forceinline__ void scan_phase(const Args& a, LAS unsigned char* lds, const bf16* Z, const float* W, const bf16* Aa, const bf16* KK, float* Y, int tid, int lane, int wave) {
    const float* mu = a.in[7];
    LAS float* buf = (LAS float*)lds;
    const int lt = tid & 255, step0 = lt >> 4, seg = lt & 15;
    const bool loader = wave >= 4;
    for (int u = blockIdx.x; u < 256; u += gridDim.x) {
        const int bh = (u & 7) + 8 * (u >> 5), rg = (u >> 3) & 3, b = bh >> 3, h = bh & 7;
        const int c = h * 64 + 4 * seg;
        const int cv = h * 64 + rg * 16 + 4 * (seg & 3);
        const f32x4 mur = *(const f32x4*)(mu + c), muk = *(const f32x4*)(mu + 512 + c), muv = *(const f32x4*)(mu + 1024 + cv), kaw = *(const f32x4*)(a.in[14] + c);
        const size_t m0 = (size_t)b * SEQ;
        u32x2 zr[2], zrp[2], zk[2], zkp[2], zv[2], zvp[2], kk4[2], a4[2]; f32x4 w4[2];
#pragma unroll
        for (int i = 0; i < 2; ++i) { zv[i] = (u32x2){0u, 0u}; zvp[i] = zv[i]; }
#define SCAN_LOAD1(t0, i) do { const int t_ = (t0) + step0 + 16 * (i); const size_t m_ = m0 + t_; const bf16* zp_ = Z + m_ * ZW; \
            zr[i] = *(const u32x2*)(zp_ + c); zk[i] = *(const u32x2*)(zp_ + 512 + c); if (seg < 4) zv[i] = *(const u32x2*)(zp_ + 1024 + cv); \
            if (t_ > 0) { zrp[i] = *(const u32x2*)(zp_ - ZW + c); zkp[i] = *(const u32x2*)(zp_ - ZW + 512 + c); if (seg < 4) zvp[i] = *(const u32x2*)(zp_ - ZW + 1024 + cv); } \
            else { zrp[i] = (u32x2){0u, 0u}; zkp[i] = zrp[i]; zvp[i] = zrp[i]; } \
            kk4[i] = *(const u32x2*)(KK + m_ * 512 + c); a4[i] = *(const u32x2*)(Aa + m_ * 512 + c); w4[i] = *(const f32x4*)(W + m_ * 512 + c); } while (0)
#define SCAN_STORE1(bi, i) do { LAS float* d_ = buf + (bi) * (SCH * SROW) + (step0 + 16 * (i)) * SROW + 4 * seg; \
            const f32x4 rc_ = bf4(zr[i]), rp_ = bf4(zrp[i]), kc_ = bf4(zk[i]), kp_ = bf4(zkp[i]), av_ = bf4(a4[i]), kkv_ = bf4(kk4[i]), wd_ = w4[i]; \
            const f32x4 r_ = rc_ + (rp_ - rc_) * mur, k_ = kc_ + (kp_ - kc_) * muk; \
            *(LAS f32x4*)(d_) = wd_; *(LAS f32x4*)(d_ + 64) = k_ * (1.0f + (av_ - 1.0f) * kaw); *(LAS f32x4*)(d_ + 128) = -kkv_; *(LAS f32x4*)(d_ + 192) = kkv_ * av_; *(LAS f32x4*)(d_ + 256) = r_; \
            if (seg < 4) { const f32x4 vc_ = bf4(zv[i]), vp_ = bf4(zvp[i]); *(LAS f32x4*)(d_ + 320) = vc_ + (vp_ - vc_) * muv; } } while (0)
#define SCAN_LOAD(t0) do { SCAN_LOAD1(t0, 0); SCAN_LOAD1(t0, 1); } while (0)
#define SCAN_STORE(bi) do { SCAN_STORE1(bi, 0); SCAN_STORE1(bi, 1); } while (0)
        if (loader) { SCAN_LOAD(0); SCAN_STORE(0); SCAN_LOAD(SCH); }
        lds_barrier();
        f32x2 S01 = {0.f, 0.f}, S23 = {0.f, 0.f};
        const bool dfirst = (u == (int)blockIdx.x);
        const int NL = gridDim.x * 4, gl = blockIdx.x * 4 + (wave - 4);
        LAS float* dscr = (LAS float*)(lds + 90112 + (wave & 3) * 8448);
        float dtv[32];
#pragma unroll
        for (int i = 0; i < 32; ++i) dtv[i] = 0.f;
        const bool consumer = wave < 4;
        const int j = lane & 15, ri = 4 * wave + (lane >> 4);
        float* yp = Y + m0 * 512 + h * 64 + rg * 16 + ri;
        for (int ch = 0; ch < SEQ / SCH; ++ch) {
            if (loader) {
                if (ch + 1 < SEQ / SCH) SCAN_STORE((ch + 1) & 1);
                if (ch + 2 < SEQ / SCH) SCAN_LOAD((ch + 2) * SCH);
                if (dfirst) {
                    const int dit = gl + (ch >> 3) * NL;
                    if (dit < DEFER_ITEMS) {
                        if ((ch & 7) == 1) { const DeferItem d = defer_decode(a, dit); transpose_load(d.W, d.K, d.N, d.item, lane, dtv); }
                        else if ((ch & 7) == 2) { const DeferItem d = defer_decode(a, dit); transpose_store(d.K, d.N, d.WT, d.mode, dscr, d.item, lane, dtv); }
                    }
                }
            }
            if (consumer) {
                const LAS float* sb = buf + (ch & 1) * (SCH * SROW) + 4 * j;
                const LAS float* vb = buf + (ch & 1) * (SCH * SROW) + 320 + ri;
                f32x4 pw[3], pk[3], pa[3], pb[3], pr[3]; float pv[3];
#pragma unroll
                for (int i = 0; i < 2; ++i) { const LAS float* p = sb + i * SROW;
                    pw[i] = *(const LAS f32x4*)p; pk[i] = *(const LAS f32x4*)(p + 64); pa[i] = *(const LAS f32x4*)(p + 128); pb[i] = *(const LAS f32x4*)(p + 192); pr[i] = *(const LAS f32x4*)(p + 256); pv[i] = vb[i * SROW]; }
                float ykA = 0.f, ykB = 0.f, yd = 0.f;
#pragma unroll
                for (int q = 0; q < SCH; ++q) {
                    const f32x4 wv = pw[q % 3], kv = pk[q % 3], av = pa[q % 3], bv = pb[q % 3], rv = pr[q % 3]; const float vv = pv[q % 3];
                    if (q + 2 < SCH) {
                        const LAS float* p = sb + (q + 2) * SROW; const int i = (q + 2) % 3;
                        pw[i] = *(const LAS f32x4*)p; pk[i] = *(const LAS f32x4*)(p + 64); pa[i] = *(const LAS f32x4*)(p + 128); pb[i] = *(const LAS f32x4*)(p + 192); pr[i] = *(const LAS f32x4*)(p + 256);
                        pv[i] = vb[(q + 2) * SROW];
                    }
                    f32x2 t2 = S01 * (f32x2){av.x, av.y}; t2 = S23 * (f32x2){av.z, av.w} + t2;
                    float sa = t2.x + t2.y;
                    sa += dppf<0xB1>(sa); yd += dppf<0xB1>(yd);
                    sa += dppf<0x4E>(sa); yd += dppf<0x4E>(yd);
                    sa += dppf<0x141>(sa); yd += dppf<0x141>(yd);
                    sa += dppf<0x140>(sa); yd += dppf<0x140>(yd);
                    if (q > 0) { if (q <= 16) ykA = (j == q - 1) ? yd : ykA; else ykB = (j == q - 17) ? yd : ykB; }
                    const f32x2 u01 = S01 * (f32x2){wv.x, wv.y} + (f32x2){kv.x, kv.y} * vv, u23 = S23 * (f32x2){wv.z, wv.w} + (f32x2){kv.z, kv.w} * vv;
                    S01 = u01 + (f32x2){bv.x, bv.y} * sa; S23 = u23 + (f32x2){bv.z, bv.w} * sa;
                    f32x2 y2 = S01 * (f32x2){rv.x, rv.y}; y2 = S23 * (f32x2){rv.z, rv.w} + y2;
                    yd = y2.x + y2.y;
                }
                yd = red16(yd); ykB = (j == 15) ? yd : ykB;
                yp[(size_t)(ch * SCH + j) * 512] = ykA;
                yp[(size_t)(ch * SCH + 16 + j) * 512] = ykB;
            }
            lds_barrier();
        }
        if (loader && dfirst) {
            for (int dit = gl + (SEQ / SCH / 8) * NL; dit < DEFER_ITEMS; dit += NL) { const DeferItem d = defer_decode(a, dit); transpose_load(d.W, d.K, d.N, d.item, lane, dtv); transpose_store(d.K, d.N, d.WT, d.mode, dscr, d.item, lane, dtv); }
        }
#undef SCAN_LOAD
#undef SCAN_STORE
#undef SCAN_LOAD1
#undef SCAN_STORE1
    }
}

__device__ __forceinline__ void e3_phase(const Args& a, LAS unsigned char* lds, const bf16* Z, const float* Y, const float* BON, const bf16* G, bf16* YC, int tid, int lane, int wave) {
    const int gw = blockIdx.x * NWAVES + wave, NGW = gridDim.x * NWAVES;
    {
        const int half = gw & 1, c = half * 256 + 4 * lane, h = c >> 6;
        const f32x4 muv = *(const f32x4*)(a.in[7] + 1024 + c), lw = *(const f32x4*)(a.in[16] + c), lb = *(const f32x4*)(a.in[17] + c);
        const int MS = NGW >> 1;
        for (int mb = gw >> 1; mb < T; mb += 4 * MS) {
            f32x4 yv[4]; u32x2 zv[4], zvp[4], gv[4]; float bn[4];
#pragma unroll
            for (int i = 0; i < 4; ++i) {
                const int m = mb + i * MS; const bool ok = m < T; const int mm = ok ? m : 0, s = mm & (SEQ - 1);
                yv[i] = *(const f32x4*)(Y + (size_t)mm * 512 + c);
                const bf16* zp = Z + (size_t)mm * ZW + 1024 + c;
                zv[i] = *(const u32x2*)zp; zvp[i] = *(const u32x2*)(s ? zp - ZW : zp); if (!s) zvp[i] = (u32x2){0u, 0u};
                gv[i] = *(const u32x2*)(G + (size_t)mm * 512 + c); bn[i] = BON[mm * 8 + h];
            }
#pragma unroll
            for (int i = 0; i < 4; ++i) {
                const int m = mb + i * MS; if (m >= T) break;
                const f32x4 y = yv[i], vc = bf4(zv[i]), vp = bf4(zvp[i]), g = bf4(gv[i]);
                const float mean = red16((y.x + y.y) + (y.z + y.w)) * (1.f / 64.f);
                const f32x4 d = y - mean;
                const float var = red16((d.x * d.x + d.y * d.y) + (d.z * d.z + d.w * d.w)) * (1.f / 64.f);
                const f32x4 yn = d * rsqrtf(var + 64e-5f) * lw + lb;
                const f32x4 v = vc + (vp - vc) * muv;
                *(u32x2*)(YC + (size_t)m * DM + c) = pk4((yn + v * bn[i]) * g);
            }
        }
    }
    {
        LAS float* gl = (LAS float*)lds;
        const int ch = tid;
        const int sr = tid >> 6, sseg = tid & 63;
        f32x4 gb1a = *(const f32x4*)(a.in[18] + 8 * sseg), gb1b = *(const f32x4*)(a.in[18] + 8 * sseg + 4), gb2a = *(const f32x4*)(a.in[18] + 512 + 8 * sseg), gb2b = *(const f32x4*)(a.in[18] + 512 + 8 * sseg + 4);
        const float dwb = a.in[20][ch];
        float dw[31];
#pragma unroll
        for (int j = 0; j < 31; ++j) dw[j] = a.in[19][j * 512 + ch];
        const f32x4 cw0 = *(const f32x4*)(a.in[21] + 4 * lane), cw1 = *(const f32x4*)(a.in[21] + 256 + 4 * lane), cb0 = *(const f32x4*)(a.in[22] + 4 * lane), cb1 = *(const f32x4*)(a.in[22] + 256 + 4 * lane);
        for (int tile = blockIdx.x; tile < T / 32; tile += gridDim.x) {
            const int m0 = tile * 32, s0 = m0 & (SEQ - 1);
            u32x4 r1[8], r2[8];
#pragma unroll
            for (int i = 0; i < 8; ++i) {
                const int tt = 8 * i + sr, s = s0 - 30 + tt; const bool ok = tt < 62 && s >= 0;
                const bf16* zp = Z + (size_t)(ok ? m0 - 30 + tt : m0) * ZW + 1792 + 8 * sseg;
                r1[i] = *(const u32x4*)zp; r2[i] = *(const u32x4*)(zp + 512);
            }
#pragma unroll
            for (int i = 0; i < 8; ++i) {
                const int tt = 8 * i + sr, s = s0 - 30 + tt;
                if (tt < 62) {
                    f32x4 o0, o1;
                    if (s >= 0) {
                        const f32x4 u1a = (f32x4){bflo(r1[i].x), bfhi(r1[i].x), bflo(r1[i].y), bfhi(r1[i].y)} + gb1a, u1b = (f32x4){bflo(r1[i].z), bfhi(r1[i].z), bflo(r1[i].w), bfhi(r1[i].w)} + gb1b;
                        const f32x4 u2a = (f32x4){bflo(r2[i].x), bfhi(r2[i].x), bflo(r2[i].y), bfhi(r2[i].y)} + gb2a, u2b = (f32x4){bflo(r2[i].z), bfhi(r2[i].z), bflo(r2[i].w), bfhi(r2[i].w)} + gb2b;
                        o0 = (f32x4){u1a.x * fsigmoid(u2a.x), u1a.y * fsigmoid(u2a.y), u1a.z * fsigmoid(u2a.z), u1a.w * fsigmoid(u2a.w)};
                        o1 = (f32x4){u1b.x * fsigmoid(u2b.x), u1b.y * fsigmoid(u2b.y), u1b.z * fsigmoid(u2b.z), u1b.w * fsigmoid(u2b.w)};
                    } else { o0 = (f32x4){0.f, 0.f, 0.f, 0.f}; o1 = o0; }
                    *(LAS f32x4*)(gl + tt * 512 + 8 * sseg) = o0; *(LAS f32x4*)(gl + tt * 512 + 8 * sseg + 4) = o1;
                }
            }
            __syncthreads();
            {
                float gv[62];
#pragma unroll
                for (int i = 0; i < 62; ++i) gv[i] = gl[i * 512 + ch];
#pragma unroll
                for (int t = 0; t < 32; ++t) {
                    float acc = dwb;
#pragma unroll
                    for (int j = 0; j < 31; ++j) acc += gv[t + j] * dw[j];
                    gl[t * 512 + ch] = acc;
                }
            }
            __syncthreads();
#pragma unroll
            for (int q = 0; q < 4; ++q) {
                const int t = 4 * wave + q;
                const f32x4 x0 = *(const LAS f32x4*)(gl + t * 512 + 4 * lane), x1 = *(const LAS f32x4*)(gl + t * 512 + 256 + 4 * lane);
                const float mean = wave_sum((x0.x + x0.y) + (x0.z + x0.w) + (x1.x + x1.y) + (x1.z + x1.w)) * (1.f / 512.f);
                const f32x4 d0 = x0 - mean, d1 = x1 - mean;
                const float var = wave_sum((d0.x * d0.x + d0.y * d0.y) + (d0.z * d0.z + d0.w * d0.w) + (d1.x * d1.x + d1.y * d1.y) + (d1.z * d1.z + d1.w * d1.w)) * (1.f / 512.f);
                const float rs = rsqrtf(var + 1e-5f);
                f32x4 y0 = d0 * rs * cw0 + cb0, y1 = d1 * rs * cw1 + cb1;
                y0.x *= fsigmoid(y0.x); y0.y *= fsigmoid(y0.y); y0.z *= fsigmoid(y0.z); y0.w *= fsigmoid(y0.w);
                y1.x *= fsigmoid(y1.x); y1.y *= fsigmoid(y1.y); y1.z *= fsigmoid(y1.z); y1.w *= fsigmoid(y1.w);
                bf16* o = YC + (size_t)(m0 + t) * DM + 512 + 4 * lane;
                *(u32x2*)o = pk4(y0); *(u32x2*)(o + 256) = pk4(y1);
            }
            __syncthreads();
        }
    }
}

__device__ __forceinline__ void qkrope_phase(const Args& a, LAS unsigned char* lds, const bf16* Z3, bf16* Qn, bf16* Kn, bf16* Vt, int tid, int lane, int wave) {
    const int gw = blockIdx.x * NWAVES + wave, NGW = gridDim.x * NWAVES;
    const float* COS = (const float*)(a.ws + WS_ROPE); const float* SIN = COS + SEQ * 32;
    {
        const int part = gw & 3, isk = part >> 1, grp = lane >> 3, j = lane & 7, gi = (part & 1) * 8 + grp, h = gi >> 1, c = gi & 1;
        const int col0 = isk * 1024 + gi * 64 + 4 * j;
        const float* nw = a.in[isk ? 26 : 25];
        const f32x4 n1 = *(const f32x4*)(nw + 4 * j), n2 = *(const f32x4*)(nw + 32 + 4 * j);
        const float sc = isk ? 1.0f : QSCALE;
        bf16* dstb = isk ? Kn : Qn;
        const int MS = NGW >> 2;
        for (int mb = gw >> 2; mb < T; mb += 4 * MS) {
            u32x2 z1[4], z2[4]; f32x4 csv[4], snv[4];
#pragma unroll
            for (int i = 0; i < 4; ++i) {
                const int m = mb + i * MS; const int mm = m < T ? m : 0, s = mm & (SEQ - 1);
                const bf16* zp = Z3 + (size_t)mm * Z3W + col0;
                z1[i] = *(const u32x2*)zp; z2[i] = *(const u32x2*)(zp + 32);
                csv[i] = *(const f32x4*)(COS + s * 32 + 4 * j); snv[i] = *(const f32x4*)(SIN + s * 32 + 4 * j);
            }
#pragma unroll
            for (int i = 0; i < 4; ++i) {
                const int m = mb + i * MS; if (m >= T) break;
                const int b = m >> 12, s = m & (SEQ - 1);
                f32x4 x1 = bf4(z1[i]), x2 = bf4(z2[i]);
                const float ss = red8((x1.x * x1.x + x1.y * x1.y) + (x1.z * x1.z + x1.w * x1.w) + (x2.x * x2.x + x2.y * x2.y) + (x2.z * x2.z + x2.w * x2.w));
                const float rs = rsqrtf(ss * (1.f / 64.f) + 1e-6f);
                x1 = x1 * rs * n1; x2 = x2 * rs * n2;
                const f32x4 o1 = (x1 * csv[i] - x2 * snv[i]) * sc, o2 = (x2 * csv[i] + x1 * snv[i]) * sc;
                bf16* d = dstb + ((size_t)(((b * 8 + h) * 2 + c)) * SEQ + s) * 64 + 4 * j;
                *(u32x2*)d = pk4(o1); *(u32x2*)(d + 32) = pk4(o2);
            }
        }
    }
    {
        LAS bf16* Vs = (LAS bf16*)lds;
        for (int it = blockIdx.x; it < 64 * 64; it += gridDim.x) {
            const int bh = it >> 6, tile = it & 63, b = bh >> 3, h = bh & 7;
            { const int tk = tid >> 3, seg = tid & 7;
              const bf16* src = Z3 + (size_t)(b * SEQ + 64 * tile + tk) * Z3W + 2048 + h * 128 + 16 * seg;
              const u32x4 v0 = *(const u32x4*)src, v1 = *(const u32x4*)(src + 8);
              *(LAS u32x4*)(Vs + tk * 136 + 16 * seg) = v0; *(LAS u32x4*)(Vs + tk * 136 + 16 * seg + 8) = v1; }
            __syncthreads();
            { const int dv = tid >> 2, qr = tid & 3; unsigned w[8];
#pragma unroll
              for (int p = 0; p < 16; p += 2) {
                  const int k0 = 16 * qr + 4 * (p >> 3) + (p & 3) + 8 * ((p & 7) >> 2), k1 = k0 + 1;
                  w[p >> 1] = (unsigned)Vs[k0 * 136 + dv] | ((unsigned)Vs[k1 * 136 + dv] << 16);
              }
              bf16* dst = Vt + ((size_t)bh * 128 + dv) * SEQ + 64 * tile + 16 * qr;
              *(u32x4*)dst = (u32x4){w[0], w[1], w[2], w[3]}; *(u32x4*)(dst + 8) = (u32x4){w[4], w[5], w[6], w[7]}; }
            __syncthreads();
        }
    }
}

constexpr int AT_KB = 9216, AT_VB = 18432, AT_BUF = AT_KB + AT_VB;
__device__ __forceinline__ void attn_phase(const Args& a, LAS unsigned char* lds, const bf16* Qn, const bf16* Kn, const bf16* Vt, bf16* O, float* stash, int tid, int lane, int wave) {
    const int n32 = lane & 31, hi = lane >> 5;
    const float lam = *(const float*)(a.ws + WS_LAM);
    const float* subn = a.in[31];
    if (wave < 4) __builtin_amdgcn_s_setprio(2);
    for (int u = blockIdx.x; u < 1024; u += gridDim.x) {
        const int ub = u & 255, bh = (ub & 7) + 8 * (ub >> 5), quad = (ub >> 3) & 3, rnd = u >> 8;
        const int qb = rnd == 0 ? quad : (rnd == 1 ? 7 - quad : (rnd == 2 ? 8 + quad : 15 - quad));
        const int b = bh >> 3, h = bh & 7;
        const int NT = 4 * qb + 4, td = 4 * qb + (wave >> 1);
        const int qloc = 32 * (wave & 1) + n32;
        for (int c = 0; c < 2; ++c) {
            const bf16* Qp = Qn + ((size_t)(bh * 2 + c) * SEQ + 256 * qb + 32 * wave + n32) * 64 + 8 * hi;
            bf16x8 qf[4];
#pragma unroll
            for (int ds = 0; ds < 4; ++ds) qf[ds] = *(const bf16x8*)(Qp + 16 * ds);
            const bf16* Kp = Kn + (size_t)(bh * 2 + c) * SEQ * 64 + tid * 8;
            const bf16* Vp = Vt + (size_t)bh * 128 * SEQ + (size_t)(tid >> 3) * SEQ + 8 * (tid & 7);
            const int kofs = (tid >> 3) * 144 + (tid & 7) * 16;
            f32x16 o[4];
#pragma unroll
            for (int i = 0; i < 4; ++i)
#pragma unroll
                for (int r = 0; r < 16; ++r) o[i][r] = 0.f;
            float mrun = -INFINITY, lsum = 0.f;
            u32x4 kreg[2], vreg0[2], vreg1[2];
            kreg[0] = gload16_asm(Kp); vreg0[0] = gload16_asm(Vp); vreg1[0] = gload16_asm(Vp + (size_t)64 * SEQ);
            kreg[1] = gload16_asm(Kp + 4096); vreg0[1] = gload16_asm(Vp + 64); vreg1[1] = gload16_asm(Vp + (size_t)64 * SEQ + 64);
            asm volatile("" :: "v"(qf[0]), "v"(qf[1]), "v"(qf[2]), "v"(qf[3]));
            asm volatile("s_waitcnt vmcnt(3)" ::: "memory");
            *(LAS u32x4*)(lds + kofs) = kreg[0]; *(LAS u32x4*)(lds + AT_KB + kofs) = vreg0[0]; *(LAS u32x4*)(lds + AT_KB + 64 * 144 + kofs) = vreg1[0];
            lds_barrier();
            for (int tp = 0; tp < NT; tp += 2) {
#pragma unroll
              for (int hh = 0; hh < 2; ++hh) {
                const int t = tp + hh;
                if (t + 2 < NT) { kreg[hh] = gload16_asm(Kp + (size_t)(t + 2) * 4096); vreg0[hh] = gload16_asm(Vp + 64 * (t + 2)); vreg1[hh] = gload16_asm(Vp + (size_t)64 * SEQ + 64 * (t + 2)); }
                if (t <= td) {
                    const LAS unsigned char* kb = lds + (t & 1) * AT_BUF + n32 * 144 + hi * 16;
                    f32x16 p0, p1;
#pragma unroll
                    for (int r = 0; r < 16; ++r) { p0[r] = 0.f; p1[r] = 0.f; }
                    bf16x8 kf0[4], kf1[4];
#pragma unroll
                    for (int ds = 0; ds < 4; ++ds) { kf0[ds] = *(const LAS bf16x8*)(kb + ds * 32); kf1[ds] = *(const LAS bf16x8*)(kb + 32 * 144 + ds * 32); }
                    const LAS unsigned char* vb = lds + (t & 1) * AT_BUF + AT_KB + n32 * 144 + hi * 16;
                    bf16x8 vf[2][4];
#pragma unroll
                    for (int i = 0; i < 4; ++i) vf[0][i] = *(const LAS bf16x8*)(vb + i * 32 * 144);
                    __builtin_amdgcn_sched_barrier(0);
                    #pragma unroll
                    for (int ds = 0; ds < 4; ++ds) {
                        p0 = __builtin_amdgcn_mfma_f32_32x32x16_bf16(kf0[ds], qf[ds], p0, 0, 0, 0);
                        p1 = __builtin_amdgcn_mfma_f32_32x32x16_bf16(kf1[ds], qf[ds], p1, 0, 0, 0);
                    }
                                        __builtin_amdgcn_sched_barrier(0);
                    if (t == td) {
                        asm volatile("" ::: "memory");
#pragma unroll
                        for (int r = 0; r < 16; ++r) { const int key = (r & 3) + 8 * (r >> 2) + 4 * hi; if (key > qloc) p0[r] = -INFINITY; if (key + 32 > qloc) p1[r] = -INFINITY; }
                    }
                    asm volatile("s_nop 15\n\ts_nop 7" : "+v"(p0), "+v"(p1));
                    float mx, mxb;
                    mx = max3f(p0[0], p0[1], p1[0]); mxb = max3f(p0[2], p0[3], p1[1]); mx = max3f(mx, p1[2], p1[3]);
#pragma unroll
                    for (int r = 4; r < 16; r += 4) { mx = max3f(mx, p0[r], p0[r + 1]); mxb = max3f(mxb, p0[r + 2], p0[r + 3]); mx = max3f(mx, p1[r], p1[r + 1]); mxb = max3f(mxb, p1[r + 2], p1[r + 3]); }
                    mx = max3f(mx, mxb, mxb);
                    { auto rr = __builtin_amdgcn_permlane32_swap(__float_as_uint(mx), __float_as_uint(mx), false, false); mx = max3f(__uint_as_float(rr[0]), __uint_as_float(rr[1]), mrun); }
                    const float mnew = mx;
                    if (__builtin_amdgcn_ballot_w64(mnew != mrun)) {
                        const float alpha = __builtin_amdgcn_exp2f(mrun - mnew);
                        lsum *= alpha;
#pragma unroll
                        for (int i = 0; i < 4; ++i) o[i] = o[i] * alpha;
                        mrun = mnew;
                    }
                    {
                        const f32x2 mm2 = {mrun, mrun};
#pragma unroll
                        for (int r = 0; r < 16; r += 2) { const f32x2 a2 = (f32x2){p0[r], p0[r + 1]} - mm2, b2 = (f32x2){p1[r], p1[r + 1]} - mm2; p0[r] = a2.x; p0[r + 1] = a2.y; p1[r] = b2.x; p1[r + 1] = b2.y; }
                    }
#pragma unroll
                    for (int r = 0; r < 16; ++r) { p0[r] = __builtin_amdgcn_exp2f(p0[r]); p1[r] = __builtin_amdgcn_exp2f(p1[r]); }
                    {
                        const f32x16 ps = p0 + p1;
                        f32x2 s2 = (f32x2){ps[0], ps[1]} + (f32x2){ps[2], ps[3]};
#pragma unroll
                        for (int r = 4; r < 16; r += 2) s2 += (f32x2){ps[r], ps[r + 1]};
                        lsum += s2.x + s2.y;
                    }
                    bf16x8 pf[4];
#pragma unroll
                    for (int s4 = 0; s4 < 4; ++s4) {
                        u32x4 w;
                        if (s4 < 2) { w.x = pk2(p0[8 * s4 + 0], p0[8 * s4 + 1]); w.y = pk2(p0[8 * s4 + 2], p0[8 * s4 + 3]); w.z = pk2(p0[8 * s4 + 4], p0[8 * s4 + 5]); w.w = pk2(p0[8 * s4 + 6], p0[8 * s4 + 7]); }
                        else { const int q = s4 - 2; w.x = pk2(p1[8 * q + 0], p1[8 * q + 1]); w.y = pk2(p1[8 * q + 2], p1[8 * q + 3]); w.z = pk2(p1[8 * q + 4], p1[8 * q + 5]); w.w = pk2(p1[8 * q + 6], p1[8 * q + 7]); }
                        pf[s4] = __builtin_bit_cast(bf16x8, w);
                    }
#pragma unroll
                    for (int s4 = 0; s4 < 4; ++s4) {
                        if (s4 + 1 < 4) {
#pragma unroll
                            for (int i = 0; i < 4; ++i) vf[(s4 + 1) & 1][i] = *(const LAS bf16x8*)(vb + i * 32 * 144 + (s4 + 1) * 32);
                        }
                        __builtin_amdgcn_sched_barrier(0);
                        #pragma unroll
                        for (int i = 0; i < 4; ++i) o[i] = __builtin_amdgcn_mfma_f32_32x32x16_bf16(vf[s4 & 1][i], pf[s4], o[i], 0, 0, 0);
                                                __builtin_amdgcn_sched_barrier(0);
                    }
                }
                if (t + 1 < NT) { if (t + 2 < NT) asm volatile("s_waitcnt vmcnt(3)" ::: "memory"); else asm volatile("s_waitcnt vmcnt(0)" ::: "memory");
                    LAS unsigned char* d = lds + ((t + 1) & 1) * AT_BUF; *(LAS u32x4*)(d + kofs) = kreg[hh ^ 1]; *(LAS u32x4*)(d + AT_KB + kofs) = vreg0[hh ^ 1]; *(LAS u32x4*)(d + AT_KB + 64 * 144 + kofs) = vreg1[hh ^ 1]; }
                lds_barrier();
              }
            }
            const float inv = 1.0f / xhalf_sum(lsum);
            int oz; asm volatile("v_mov_b32 %0, 0" : "=v"(oz));
            float* st = stash + ((size_t)blockIdx.x * 8 + wave) * 4096 + lane + oz;
            if (c == 0) {
#pragma unroll
                for (int i = 0; i < 4; ++i)
#pragma unroll
                    for (int r = 0; r < 16; ++r) st[(i * 16 + r) * 64] = o[i][r] * inv;
            } else {
                float ss = 0.f;
#pragma unroll
                for (int i = 0; i < 4; ++i) {
                    float tv[16];
#pragma unroll
                    for (int r = 0; r < 16; ++r) tv[r] = st[(i * 16 + r) * 64];
                    asm volatile("" ::: "memory");
#pragma unroll
                    for (int r = 0; r < 16; ++r) { const float v = tv[r] - lam * (o[i][r] * inv); o[i][r] = v; ss += v * v; }
                }
                ss = xhalf_sum(ss);
                const float rs = rsqrtf(ss * (1.f / 128.f) + 1e-5f) * (1.0f - LAM_INIT);
                bf16* op = O + (size_t)(b * SEQ + 256 * qb + 32 * wave + n32 + oz) * DM + h * 128 + 4 * hi;
#pragma unroll
                for (int i = 0; i < 4; ++i)
#pragma unroll
                    for (int r4 = 0; r4 < 4; ++r4) {
                        const f32x4 sn = *(const f32x4*)(subn + 32 * i + 8 * r4 + 4 * hi);
                        const f32x4 v = (f32x4){o[i][4 * r4], o[i][4 * r4 + 1], o[i][4 * r4 + 2], o[i][4 * r4 + 3]} * rs * sn;
                        *(u32x2*)(op + 32 * i + 8 * r4) = pk4(v);
                    }
            }
        }
    }
    __builtin_amdgcn_s_setprio(0);
}

#define XB_TMO      128
#define XB_XCNT(j)  (256  + 64 * (j))
#define XB_XSUB(j)  (1280 + 64 * (j))
#define XB_XGEN(j)  (2304 + 64 * (j))
#define XB_TOP      3328
#define XB_TOPGEN   3392
#define XCD_BAR_WORDS 3456
#define XB_SPIN_CAP (1u << 18)

__device__ __forceinline__ unsigned xb_ld(unsigned* p)              { return __hip_atomic_load(p, __ATOMIC_RELAXED, __HIP_MEMORY_SCOPE_AGENT); }
__device__ __forceinline__ unsigned xb_add(unsigned* p, unsigned v) { return __hip_atomic_fetch_add(p, v, __ATOMIC_RELAXED, __HIP_MEMORY_SCOPE_AGENT); }
__device__ __forceinline__ unsigned xb_xcc_id() { return (unsigned)__builtin_amdgcn_s_getreg((3 << 11) | 20) & 0xFu; }
#define XB_SPIN(cond, bar) do { unsigned _sp = 0; while (cond) { __builtin_amdgcn_s_sleep(1); \
    if ((++_sp & 255u) == 0u) { if (xb_ld(&(bar)[XB_TMO])) break; if (_sp > XB_SPIN_CAP) { atomicAdd(&(bar)[XB_TMO], 1u); break; } } } } while (0)

struct XcdBarrier {
    unsigned* bar; unsigned x;
    volatile LAS unsigned* st;
};

__device__ __forceinline__ XcdBarrier xcd_barrier_post(unsigned* bar, volatile LAS unsigned* st) {
    XcdBarrier b; b.bar = bar; b.x = xb_xcc_id(); b.st = st;
    if (threadIdx.x == 0) (void)xb_add(&bar[XB_XCNT(b.x)], 1u);
    return b;
}
__device__ __forceinline__ void xcd_barrier_complete(unsigned* bar, unsigned x, unsigned& nloc, unsigned& nx) {
    const unsigned G = gridDim.x * gridDim.y * gridDim.z;
    unsigned sum, cnt, mine, sp = 0u;
    for (;;) {
        sum = 0u; cnt = 0u; mine = 0u;
#pragma unroll
        for (unsigned j = 0; j < 16; ++j) { const unsigned c = xb_ld(&bar[XB_XCNT(j)]); sum += c; cnt += (c > 0u) ? 1u : 0u; mine = (j == x) ? c : mine; }
        if (sum == G) break;
        __builtin_amdgcn_s_sleep(1);
        if ((++sp & 255u) == 0u) { if (xb_ld(&bar[XB_TMO])) break; if (sp > XB_SPIN_CAP) { atomicAdd(&bar[XB_TMO], 1u); break; } }
    }
    nloc = mine > 0u ? mine : 1u; nx = cnt > 0u ? cnt : 1u;
}

__device__ __forceinline__ void xcd_barrier(const XcdBarrier& b) {
    asm volatile("s_waitcnt vmcnt(0)" ::: "memory");
    __syncthreads();
    if (threadIdx.x == 0) {
        unsigned* bar = b.bar;
        __builtin_amdgcn_s_waitcnt(0);
        unsigned nloc = b.st[0], nx = b.st[1];
        if (nloc == 0u) { xcd_barrier_complete(bar, b.x, nloc, nx); b.st[0] = nloc; b.st[1] = nx; }
        const unsigned old = xb_add(&bar[XB_XSUB(b.x)], 1u);
        const unsigned gen = old / nloc;
        if (old + 1u == (gen + 1u) * nloc) {
            __builtin_amdgcn_fence(__ATOMIC_RELEASE, "agent");
            asm volatile("s_waitcnt vmcnt(0)" ::: "memory");
            const unsigned og = xb_add(&bar[XB_TOP], 1u);
            const unsigned tg = og / nx;
            if (og + 1u == (tg + 1u) * nx) xb_add(&bar[XB_TOPGEN], 1u);
            else XB_SPIN(xb_ld(&bar[XB_TOPGEN]) == tg, bar);
            __builtin_amdgcn_fence(__ATOMIC_ACQUIRE, "agent");
            xb_add(&bar[XB_XGEN(b.x)], 1u);
            asm volatile("s_waitcnt vmcnt(0)" ::: "memory");
        } else {
            XB_SPIN(xb_ld(&bar[XB_XGEN(b.x)]) == gen, bar);
            __builtin_amdgcn_fence(__ATOMIC_ACQUIRE, "agent");
            asm volatile("s_waitcnt vmcnt(0)" ::: "memory");
        }
    }
    __syncthreads();
}

#ifndef KMASK
#define KMASK 0xffff
#endif
#define KON(k) ((KMASK >> (k)) & 1)
constexpr int N_PHASES = 20;
__global__ void __launch_bounds__(NTHR, 2) mega_fwd(Args a) {
    extern __shared__ __attribute__((aligned(16))) unsigned char lds_raw[];
    LAS unsigned char* lds = (LAS unsigned char*)lds_raw;
    cg::grid_group grid = cg::this_grid();
    volatile LAS unsigned* bst = (volatile LAS unsigned*)(lds + 131072);
    if (threadIdx.x < 2) bst[threadIdx.x] = 0u;
    __syncthreads();
    const XcdBarrier xbar = xcd_barrier_post((unsigned*)(a.ws + WS_BAR), bst);
#ifndef KREP
#define KREP 0
#endif
    int rep = 0; (void)rep;
    for (int ph = a.ph_lo; ph < a.ph_hi; ++ph) {
        int oz; asm volatile("s_mov_b32 %0, 0" : "=s"(oz));
        const int tid = threadIdx.x + oz, lane = tid & 63, wave = __builtin_amdgcn_readfirstlane(tid >> 6);
        const int gw = blockIdx.x * NWAVES + wave, NGW = gridDim.x * NWAVES;
        unsigned char* ws = a.ws + oz;
        bf16* XN = (bf16*)(ws + WS_XN);
        bf16* BIG = (bf16*)(ws + WS_BIG);
        float* X = a.out + oz;
        int kind = 0, idx = 0;
        switch (ph) {
            case 0: kind = 0; break;
            case 1: kind = 1; idx = 0; break;
            case 2: kind = 2; idx = 0; break;
            case 3: kind = 4; idx = 0; break;
            case 4: kind = 5; break;
            case 5: kind = 6; break;
            case 6: kind = 7; break;
            case 7: kind = 8; break;
            case 8: kind = 9; break;
            case 9: kind = 10; idx = 0; break;
            case 10: kind = 1; idx = 1; break;
            case 11: kind = 2; idx = 1; break;
            case 12: kind = 1; idx = 2; break;
            case 13: kind = 2; idx = 2; break;
            case 14: kind = 4; idx = 1; break;
            case 15: kind = 11; break;
            case 16: kind = 12; break;
            case 17: kind = 10; idx = 1; break;
            case 18: kind = 1; idx = 3; break;
            default: kind = 2; idx = 3; break;
        }
        float* RSQ = (float*)(ws + WS_RSQ);
        if (kind == 0) { if (KON(0))
            prologue_phase(a, lds, tid, lane, wave);
        } else if (kind == 1) { if (KON(1)) {
            EpiSwiGLU E{BIG, ph == 1 ? (const float*)nullptr : (const float*)RSQ};
            run_gemm(lds, XN, (const bf16*)(ws + WS_WGU + idx * WGU_STRIDE), 2 * DFF, DM, E); }
        } else if (kind == 2 || kind == 10) { if (KON(2)) {
            const bool dn = kind == 2;
            const float* gn = ph == 2 ? a.in[5] : (ph == 9 ? a.in[1] + DM : (ph == 11 ? a.in[1] + 2 * DM : (ph == 13 ? a.in[5] + DM : (ph == 17 ? a.in[1] + 3 * DM : (const float*)nullptr))));
            EpiResid E{ph == 2 ? a.in[0] : (const float*)X, X, gn, XN, RSQ, dn ? 0.5f : 1.0f, 0.f};
            const bf16* A = dn ? (const bf16*)BIG : (idx == 0 ? (const bf16*)(ws + WS_R1) : (const bf16*)BIG);
            const bf16* Bt = dn ? (const bf16*)(ws + WS_WD + idx * WD_STRIDE) : (const bf16*)(ws + (idx == 0 ? WS_WEOUT : WS_WCOUT));
            run_gemm(lds, A, Bt, DM, dn ? DFF : DM, E); }
        } else if (kind == 4) { if (KON(4)) {
            EpiStore E{BIG, idx == 0 ? ZW : Z3W, (const float*)RSQ};
            run_gemm(lds, XN, (const bf16*)(ws + (idx == 0 ? WS_WAIN : WS_WCIN)), idx == 0 ? ZW : Z3W, DM, E); }
        } else if (kind == 5) { if (KON(5))
            e1_phase(BIG, a.in[7], (bf16*)(ws + WS_LRIN), tid);
        } else if (kind == 6) { if (KON(6)) {
            EpiLowRank E{(float*)(ws + WS_R1), (bf16*)(ws + WS_R2), (bf16*)(ws + WS_R4), a.in[8], a.in[10]};
            run_gemm(lds, (const bf16*)(ws + WS_LRIN), (const bf16*)(ws + WS_WBD), 1536, 256, E); }
        } else if (kind == 7) { if (KON(7))
            e2_phase(a, BIG, (bf16*)(ws + WS_R2), (float*)(ws + WS_R1), (bf16*)(ws + WS_R3), (float*)(ws + WS_BON), gw, NGW, lane);
        } else if (kind == 8) { if (KON(8))
            scan_phase(a, lds, BIG, (const float*)(ws + WS_R1), (const bf16*)(ws + WS_R2), (const bf16*)(ws + WS_R3), (float*)(ws + WS_XN), tid, lane, wave);
        } else if (kind == 9) { if (KON(9))
            e3_phase(a, lds, BIG, (const float*)(ws + WS_XN), (const float*)(ws + WS_BON), (const bf16*)(ws + WS_R4), (bf16*)(ws + WS_R1), tid, lane, wave);
        } else if (kind == 11) { if (KON(11))
            qkrope_phase(a, lds, BIG, (bf16*)(ws + WS_XN), (bf16*)(ws + WS_R1), (bf16*)(ws + WS_R2), tid, lane, wave);
        } else { if (KON(12))
            attn_phase(a, lds, (const bf16*)(ws + WS_XN), (const bf16*)(ws + WS_R1), (const bf16*)(ws + WS_R2), BIG, (float*)(ws + WS_BIG + 64 * MiB), tid, lane, wave);
        }
#if KREP
        if (!rep && ((KREP >> kind) & 1)) { rep = 1; --ph; } else rep = 0;
#endif
        if (ph + 1 < a.ph_hi) {
            if (ph == a.ph_lo) grid.sync(); else xcd_barrier(xbar);
        }
    }
}

#ifndef MK_PER_PHASE
#define MK_PER_PHASE 0
#endif
extern "C" void kernel_launch(void* const* d_in, const int* in_sizes, int n_in, void* d_out, int out_size, void* d_ws, size_t ws_size, hipStream_t stream) {
    static int grid = 0;
    if (grid == 0) {
        if (n_in != 33 || out_size != T * DM || ws_size < WS_END) { fprintf(stderr, "kernel_launch: unexpected shapes (n_in %d out %d ws %zu)\n", n_in, out_size, ws_size); grid = -1; return; }
        int dev = 0, cus = 0, per_cu = 0;
        hipGetDevice(&dev);
        hipDeviceGetAttribute(&cus, hipDeviceAttributeMultiprocessorCount, dev);
        if (hipFuncSetAttribute((const void*)mega_fwd, hipFuncAttributeMaxDynamicSharedMemorySize, LDS_BYTES) != hipSuccess) { fprintf(stderr, "kernel_launch: hipFuncSetAttribute failed\n"); grid = -1; return; }
        if (hipOccupancyMaxActiveBlocksPerMultiprocessor(&per_cu, (const void*)mega_fwd, NTHR, LDS_BYTES) != hipSuccess || per_cu < 1) { fprintf(stderr, "kernel_launch: occupancy query says %d\n", per_cu); per_cu = 1; }
        (void)hipGetLastError();
        grid = cus * per_cu;
    }
    if (grid < 0) return;
    if (hipMemsetAsync((char*)d_ws + WS_BAR, 0, 16384, stream) != hipSuccess) { fprintf(stderr, "kernel_launch: memset of the barrier words failed\n"); return; }
    Args a{};
    for (int i = 0; i < 33; ++i) a.in[i] = (const float*)d_in[i];
    a.out = (float*)d_out; a.ws = (unsigned char*)d_ws;
#if MK_PER_PHASE
    for (int ph = 0; ph < N_PHASES; ++ph) { a.ph_lo = ph; a.ph_hi = ph + 1; hipLaunchKernelGGL(mega_fwd, dim3(grid), dim3(NTHR), LDS_BYTES, stream, a); }
#else
    a.ph_lo = 0; a.ph_hi = N_PHASES;
    void* kargs[] = {&a};
    hipError_t e = hipLaunchCooperativeKernel((const void*)mega_fwd, dim3(grid), dim3(NTHR), kargs, LDS_BYTES, stream);
    if (e != hipSuccess) fprintf(stderr, "cooperative launch failed: %s (grid %d)\n", hipGetErrorString(e), grid);
#endif
}
```

```cpp
#include <hip/hip_runtime.h>
#include <hip/hip_cooperative_groups.h>
#include <cstdio>
#include <cstdint>
#include <cmath>
namespace cg = cooperative_groups;
namespace pg8 {
#define PG8_LAS __attribute__((address_space(3)))
typedef unsigned short bf16_t;
typedef short bf16x8 __attribute__((ext_vector_type(8)));
typedef float f32x4 __attribute__((ext_vector_type(4)));
typedef unsigned u32x4 __attribute__((ext_vector_type(4)));
constexpr int BM = 256, BK = 64, HALF = 128, HTB = HALF * BK * 2  , STAGE_BYTES = 8 * HTB, NXCD = 8, WGM = 8;

__host__ __device__ __forceinline__ int lds_byte(int r, int c) { const int st = (r >> 4) * 2 + (c >> 5), rr = r & 15, cc = c & 31, ob = rr * 64 + cc * 2; return st * 1024 + (ob ^ (((ob >> 9) & 1) << 5)); }
__host__ __device__ __forceinline__ void stage_rc(int b, int& R, int& C) { const int st = b / 1024, sb = b % 1024, swz = sb ^ (((sb >> 9) & 1) << 5); R = (st >> 1) * 16 + swz / 64; C = (st & 1) * 32 + (swz % 64) / 2; }
__host__ __device__ __forceinline__ int perm32(int rho) { const int n = rho >> 4, i = rho & 15; return 8 * (i >> 2) + 4 * n + (i & 3); }

struct Unit { int pm, pn; };
struct Gemm { const bf16_t* A; const bf16_t* Bt; int M, N, K; };

struct StaticOrder {
    int nM, nN, nwg, G, c;
    __host__ __device__ void init(int M, int N, int G_, int c_) { nM = M / BM; nN = N / BM; nwg = nM * nN; G = G_; c = c_; }
    __host__ __device__ bool next(int i, Unit& u) const {
        const long L = (long)i * G + c; if (L >= nwg) return false;
        int wgid = (int)L; { const int q = nwg / NXCD, r = nwg % NXCD, xcd = wgid % NXCD, off = wgid / NXCD; wgid = (xcd < r ? xcd * (q + 1) : r * (q + 1) + (xcd - r) * q) + off; }
        const int nig = WGM * nN, gid = wgid / nig, fm = gid * WGM, gsz = (nM - fm) < WGM ? (nM - fm) : WGM;
        u.pm = fm + ((wgid % nig) % gsz); u.pn = (wgid % nig) / gsz; return true;
    }
    __device__ __forceinline__ void a_ready(const Unit&) const {}
    __device__ __forceinline__ void done(const Unit&) const {}
};

__device__ __forceinline__ unsigned cvt_pk_bf16(float lo, float hi) { unsigned r; asm volatile("v_cvt_pk_bf16_f32 %0, %1, %2" : "=v"(r) : "v"(lo), "v"(hi)); return r; }
typedef float f32x2 __attribute__((ext_vector_type(2)));
__device__ __forceinline__ f32x2 gelu_pk(f32x2 v) {
    const f32x2 av = __builtin_elementwise_abs(v), d = av * 0.2316418882f + 1.0f;
    f32x2 t; t.x = __builtin_amdgcn_rcpf(d.x); t.y = __builtin_amdgcn_rcpf(d.y);
    f32x2 q = t * 0.5307027145f + (-0.7265760135f); q = q * t + 0.7107068705f; q = q * t + (-0.142248368f); q = q * t + 0.127414796f; q = q * t;
    const f32x2 s = (v * v) * (-0.72134752044f);
    f32x2 e; e.x = __builtin_amdgcn_exp2f(s.x); e.y = __builtin_amdgcn_exp2f(s.y);
    const f32x2 m = v * (q * e), r = v - m;
    f32x2 o; o.x = v.x < 0.f ? m.x : r.x; o.y = v.y < 0.f ? m.y : r.y; return o;
}

template <int ACT  > struct EpiBf16 {
    static constexpr bool PERM = true, AFTER_DRAIN = false; static_assert(ACT == 0 || ACT == 1, "EpiBf16: ACT is 0 (none) or 1 (gelu_pk)");
    bf16_t* O; int ldc; const float* bias; int split_cols; size_t split_stride; float scale0;
    __device__ __forceinline__ void operator()(const f32x4 (&acc)[2][2][4][2], const Unit& u, int wr, int wc, int fr, int fq) const {
        const int row0 = u.pm * BM + wr * 64 + fr; int colt = u.pn * BM; bf16_t* base = O;
        float sc = 1.f; if (split_cols) { const int t = colt / split_cols; base += (size_t)t * split_stride; colt -= t * split_cols; if (t == 0) sc = scale0; }
        const int col0 = colt + wc * 32 + 8 * fq, bcol0 = u.pn * BM + wc * 32 + 8 * fq;
        f32x4 bv[2][2];
#pragma unroll
        for (int bj = 0; bj < 2; ++bj)
#pragma unroll
            for (int n = 0; n < 2; ++n) bv[bj][n] = bias ? *(const f32x4*)(bias + bcol0 + bj * HALF + 4 * n) : (f32x4){0.f, 0.f, 0.f, 0.f};
#pragma unroll
        for (int ai = 0; ai < 2; ++ai)
#pragma unroll
            for (int m = 0; m < 4; ++m) { bf16_t* rowp = base + (size_t)(row0 + ai * HALF + m * 16) * ldc + col0;
#pragma unroll
                for (int bj = 0; bj < 2; ++bj) { f32x4 v0 = acc[ai][bj][m][0] + bv[bj][0], v1 = acc[ai][bj][m][1] + bv[bj][1];
                    if (ACT == 1) { f32x2 a = gelu_pk((f32x2){v0[0], v0[1]}), b = gelu_pk((f32x2){v0[2], v0[3]}), c = gelu_pk((f32x2){v1[0], v1[1]}), d = gelu_pk((f32x2){v1[2], v1[3]});
                        v0 = (f32x4){a.x, a.y, b.x, b.y}; v1 = (f32x4){c.x, c.y, d.x, d.y}; }
                    v0 = v0 * sc; v1 = v1 * sc; u32x4 w; w.x = cvt_pk_bf16(v0[0], v0[1]); w.y = cvt_pk_bf16(v0[2], v0[3]); w.z = cvt_pk_bf16(v1[0], v1[1]); w.w = cvt_pk_bf16(v1[2], v1[3]);
                    *(u32x4*)(rowp + bj * HALF) = w; } }
    }
};
template <class Epi, class Sched, bool ALIGN_EPI = false, bool SP2 = false>
__device__ __forceinline__ void gemm_phase(PG8_LAS unsigned char* lds, const Gemm g, const Sched& S, const Epi& E) {
    int oz_; asm volatile("s_mov_b32 %0, 0" : "=s"(oz_));
    const int tid = threadIdx.x + oz_, wid = __builtin_amdgcn_readfirstlane(tid >> 6), lane = tid & 63, wr = wid >> 2, wc = wid & 3, fr = lane & 15, fq = lane >> 4;
    const int K = g.K, nt = K / BK;
    unsigned voffA[2], voffB[2];
#pragma unroll
    for (int i = 0; i < 2; ++i) { int R, C; stage_rc(tid * 16 + i * 8192, R, C); const int Rb = Epi::PERM ? ((R & ~31) + perm32(R & 31)) : R;
        voffA[i] = (unsigned)(R * K + C) * 2u; voffB[i] = (unsigned)(Rb * K + C) * 2u; }
    const size_t kstep = (size_t)(BK * 2);
    const size_t hstep = (size_t)HALF * K * 2;
    const size_t tstep = 2 * hstep;
    const unsigned ldsw = (unsigned)wid * 1024u;
    const int aoff = lds_byte(wr * 64 + fr, fq * 8), boff = lds_byte(wc * 32 + fr, fq * 8);
#define PG8_SA(b, h) (((b) * 2 + (h)) * HTB)
#define PG8_SB(b, h) ((4 + (b) * 2 + (h)) * HTB)
#define PG8_STAGE(bufoff, gbase, voff) do { _Pragma("unroll") for (int _i = 0; _i < 2; ++_i) \
        __builtin_amdgcn_global_load_lds((const unsigned*)((const char*)(gbase) + (voff)[_i]), (PG8_LAS unsigned*)(lds + (bufoff) + ldsw + _i * 8192), 16, 0, 0); } while (0)
#define PG8_LDA(dst, b, h) do { _Pragma("unroll") for (int m = 0; m < 4; ++m) _Pragma("unroll") for (int k = 0; k < 2; ++k) dst[m][k] = *(const PG8_LAS bf16x8*)(lds + PG8_SA(b, h) + aoff + m * 2048 + k * 1024); } while (0)
#define PG8_LDB(dst, b, h) do { _Pragma("unroll") for (int n = 0; n < 2; ++n) _Pragma("unroll") for (int k = 0; k < 2; ++k) dst[n][k] = *(const PG8_LAS bf16x8*)(lds + PG8_SB(b, h) + boff + n * 2048 + k * 1024); } while (0)
#define PG8_MMA(ai, bj, At, Bt) do { __builtin_amdgcn_s_setprio(1); _Pragma("unroll") for (int m = 0; m < 4; ++m) _Pragma("unroll") for (int n = 0; n < 2; ++n) _Pragma("unroll") for (int k = 0; k < 2; ++k) \
        acc[ai][bj][m][n] = __builtin_amdgcn_mfma_f32_16x16x32_bf16(Bt[n][k], At[m][k], acc[ai][bj][m][n], 0, 0, 0); __builtin_amdgcn_s_setprio(0); } while (0)
#define PG8_WAIT_V(n) asm volatile("s_waitcnt vmcnt(" #n ")" ::: "memory")
#define PG8_WAIT_L(n) asm volatile("s_waitcnt lgkmcnt(" #n ")" ::: "memory")
#define PG8_BAR __builtin_amdgcn_s_barrier()
#define PG8_SCHED __builtin_amdgcn_sched_barrier(0)
    Unit cur, nxt; int ui = 0;
    if (!S.next(0, cur)) return;
    f32x4 acc[2][2][4][2];
#pragma unroll
    for (int a = 0; a < 2; ++a)
#pragma unroll
        for (int b = 0; b < 2; ++b)
#pragma unroll
            for (int m = 0; m < 4; ++m)
#pragma unroll
                for (int n = 0; n < 2; ++n) acc[a][b][m][n] = (f32x4){0.f, 0.f, 0.f, 0.f};
    bf16x8 At[4][2], B0[2][2], B1[2][2];
    const char* cA = (const char*)g.A + (size_t)cur.pm * tstep; const char* cB = (const char*)g.Bt + (size_t)cur.pn * tstep;
    S.a_ready(cur);
    if constexpr (SP2) {
        PG8_STAGE(PG8_SB(0, 0), cB, voffB); PG8_STAGE(PG8_SB(0, 1), cB + hstep, voffB); PG8_STAGE(PG8_SA(0, 0), cA, voffA); PG8_STAGE(PG8_SA(0, 1), cA + hstep, voffA);
        if (wr == 1) PG8_BAR;
        PG8_WAIT_V(2); PG8_BAR;
        PG8_STAGE(PG8_SB(1, 0), cB + kstep, voffB); PG8_STAGE(PG8_SA(1, 0), cA + kstep, voffA); PG8_STAGE(PG8_SB(1, 1), cB + hstep + kstep, voffB);
        PG8_WAIT_V(6); PG8_BAR;
    } else {
        PG8_STAGE(PG8_SB(0, 0), cB, voffB); PG8_STAGE(PG8_SA(0, 0), cA, voffA); PG8_STAGE(PG8_SB(0, 1), cB + hstep, voffB); PG8_STAGE(PG8_SA(0, 1), cA + hstep, voffA);
        if (wr == 1) PG8_BAR;
        PG8_WAIT_V(4); PG8_BAR;
        PG8_STAGE(PG8_SB(1, 0), cB + kstep, voffB); PG8_STAGE(PG8_SA(1, 0), cA + kstep, voffA); PG8_STAGE(PG8_SB(1, 1), cB + hstep + kstep, voffB);
        PG8_WAIT_V(6); PG8_BAR;
    }
    for (;;) {
        const bool has_next = S.next(ui + 1, nxt);
        const char* nA = has_next ? (const char*)g.A + (size_t)nxt.pm * tstep : cA; const char* nB = has_next ? (const char*)g.Bt + (size_t)nxt.pn * tstep : cB;
        for (int t = 0; t < nt; t += 2) {
            const bool last = (t == nt - 2);
            const char* a1 = cA + (size_t)(t + 1) * kstep;
            const char* a2 = last ? nA : cA + (size_t)(t + 2) * kstep; const char* b2 = last ? nB : cB + (size_t)(t + 2) * kstep;
            const char* a3 = a2 + kstep; const char* b3 = b2 + kstep;
            if (last && has_next) S.a_ready(nxt);
            if constexpr (SP2) {
            PG8_LDB(B0, 0, 0); PG8_LDB(B1, 0, 1); PG8_SCHED; PG8_LDA(At, 0, 0); PG8_STAGE(PG8_SA(1, 1), a1 + hstep, voffA);
            PG8_WAIT_V(8); PG8_WAIT_L(0); PG8_BAR; PG8_MMA(0, 0, At, B0); PG8_MMA(0, 1, At, B1); PG8_BAR; PG8_SCHED;
            PG8_LDA(At, 0, 1); PG8_STAGE(PG8_SB(0, 0), b2, voffB); PG8_STAGE(PG8_SB(0, 1), b2 + hstep, voffB); PG8_STAGE(PG8_SA(0, 0), a2, voffA);
            PG8_WAIT_V(8); PG8_WAIT_L(0); PG8_BAR; PG8_MMA(1, 0, At, B0); PG8_MMA(1, 1, At, B1); PG8_BAR; PG8_SCHED;
            PG8_LDB(B0, 1, 0); PG8_LDB(B1, 1, 1); PG8_SCHED; PG8_LDA(At, 1, 0); PG8_STAGE(PG8_SA(0, 1), a2 + hstep, voffA);
            PG8_WAIT_V(8); PG8_WAIT_L(0); PG8_BAR; PG8_MMA(0, 0, At, B0); PG8_MMA(0, 1, At, B1); PG8_BAR; PG8_SCHED;
            PG8_LDA(At, 1, 1); PG8_STAGE(PG8_SB(1, 0), b3, voffB); PG8_STAGE(PG8_SB(1, 1), b3 + hstep, voffB); PG8_STAGE(PG8_SA(1, 0), a3, voffA);
            PG8_WAIT_V(8); PG8_WAIT_L(0); PG8_BAR; PG8_MMA(1, 0, At, B0); PG8_MMA(1, 1, At, B1); PG8_BAR; PG8_SCHED;
            } else {
            PG8_LDB(B0, 0, 0); PG8_SCHED; PG8_LDA(At, 0, 0); PG8_STAGE(PG8_SA(1, 1), a1 + hstep, voffA);
            PG8_WAIT_L(8); PG8_BAR; PG8_WAIT_L(0); PG8_MMA(0, 0, At, B0); PG8_BAR; PG8_SCHED;
            PG8_LDB(B1, 0, 1); PG8_STAGE(PG8_SB(0, 0), b2, voffB);
            PG8_BAR; PG8_WAIT_L(0); PG8_MMA(0, 1, At, B1); PG8_BAR;
            PG8_LDA(At, 0, 1); PG8_STAGE(PG8_SA(0, 0), a2, voffA);
            PG8_BAR; PG8_WAIT_L(0); PG8_MMA(1, 0, At, B0); PG8_BAR; PG8_SCHED;
            PG8_STAGE(PG8_SB(0, 1), b2 + hstep, voffB);
            PG8_WAIT_V(6); PG8_BAR; PG8_MMA(1, 1, At, B1); PG8_BAR;
            PG8_LDB(B0, 1, 0); PG8_SCHED; PG8_LDA(At, 1, 0); PG8_STAGE(PG8_SA(0, 1), a2 + hstep, voffA);
            PG8_WAIT_L(8); PG8_BAR; PG8_WAIT_L(0); PG8_MMA(0, 0, At, B0); PG8_BAR; PG8_SCHED;
            PG8_LDB(B1, 1, 1); PG8_STAGE(PG8_SB(1, 0), b3, voffB);
            PG8_BAR; PG8_WAIT_L(0); PG8_MMA(0, 1, At, B1); PG8_BAR;
            PG8_LDA(At, 1, 1); PG8_STAGE(PG8_SA(1, 0), a3, voffA);
            PG8_BAR; PG8_WAIT_L(0); PG8_MMA(1, 0, At, B0); PG8_BAR; PG8_SCHED;
            PG8_STAGE(PG8_SB(1, 1), b3 + hstep, voffB);
            PG8_WAIT_V(6); PG8_BAR; PG8_MMA(1, 1, At, B1); PG8_BAR;
            }
        }
        if constexpr (ALIGN_EPI) { if (wr == 0) PG8_BAR; }
        if constexpr (!Epi::AFTER_DRAIN) { E(acc, cur, wr, wc, fr, fq); S.done(cur); }
        if (!has_next) break;
#pragma unroll
        for (int a = 0; a < 2; ++a)
#pragma unroll
            for (int b = 0; b < 2; ++b)
#pragma unroll
                for (int m = 0; m < 4; ++m)
#pragma unroll
                    for (int n = 0; n < 2; ++n) acc[a][b][m][n] = (f32x4){0.f, 0.f, 0.f, 0.f};
        cur = nxt; cA = nA; cB = nB; ++ui;
        if constexpr (ALIGN_EPI) { if (wr == 1) PG8_BAR; }
    }
    PG8_WAIT_V(0);
    if constexpr (!ALIGN_EPI) { if (wr == 0) PG8_BAR; }
    PG8_BAR;
    if constexpr (Epi::AFTER_DRAIN) { E.fused(acc, cur, wr, wc, fr, fq, lds, wid, lane); S.done(cur); }
#undef PG8_SA
#undef PG8_SB
#undef PG8_STAGE
#undef PG8_LDA
#undef PG8_LDB
#undef PG8_MMA
#undef PG8_WAIT_V
#undef PG8_WAIT_L
#undef PG8_BAR
#undef PG8_SCHED
}
}

#define LAS __attribute__((address_space(3)))
typedef unsigned short bf16;
typedef float f32x4 __attribute__((ext_vector_type(4)));
typedef float f32x2 __attribute__((ext_vector_type(2)));
typedef float f32x16 __attribute__((ext_vector_type(16)));
typedef short bf16x8 __attribute__((ext_vector_type(8)));
typedef unsigned u32x4 __attribute__((ext_vector_type(4)));
typedef unsigned u32x2 __attribute__((ext_vector_type(2)));
typedef __bf16 bf16x2_t __attribute__((ext_vector_type(2)));

constexpr int NWAVES = 8, NTHR = 512;
constexpr int BATCH = 8, SEQ = 4096, DM = 1024, T = BATCH * SEQ, DFF = 2816;
constexpr int ZW = 2816;
constexpr int Z3W = 3072;
constexpr int LDS_BYTES = 147456;
constexpr float LAM_INIT = 0.35550906759096934f;
constexpr float QSCALE = 0.125f * 1.4426950408889634f;

constexpr size_t MiB = 1u << 20;
constexpr size_t WS_WGU = 0;
constexpr size_t WGU_STRIDE = (size_t)5632 * 1024 * 2;
constexpr size_t WS_WD = 44 * MiB;
constexpr size_t WD_STRIDE = (size_t)1024 * 2816 * 2;
constexpr size_t WS_WAIN = 66 * MiB;
constexpr size_t WS_WEOUT = 72 * MiB;
constexpr size_t WS_WCIN = 74 * MiB;
constexpr size_t WS_WCOUT = 80 * MiB;
constexpr size_t WS_WBD = 82 * MiB;
constexpr size_t WS_ROPE = 83 * MiB;
constexpr size_t WS_BON = 84 * MiB;
constexpr size_t WS_LAM = 85 * MiB;
constexpr size_t WS_BAR = 85 * MiB + 65536;
constexpr size_t WS_RSQ = 86 * MiB;
constexpr size_t WS_XN = 88 * MiB;
constexpr size_t WS_BIG = 152 * MiB;
constexpr size_t WS_LRIN = 328 * MiB;
constexpr size_t WS_R1 = 344 * MiB;
constexpr size_t WS_R2 = 408 * MiB;
constexpr size_t WS_R3 = 440 * MiB;
constexpr size_t WS_R4 = 472 * MiB;
constexpr size_t WS_END = 504 * MiB;

__device__ const float ROPE_INV[32] = {
    1.000000000e+00f, 7.498942018e-01f, 5.623413324e-01f, 4.216965139e-01f, 3.162277639e-01f, 2.371373922e-01f, 1.778279394e-01f, 1.333521456e-01f,
    1.000000015e-01f, 7.498941571e-02f, 5.623412877e-02f, 4.216964915e-02f, 3.162277862e-02f, 2.371373586e-02f, 1.778279431e-02f, 1.333521493e-02f,
    9.999999776e-03f, 7.498942316e-03f, 5.623413250e-03f, 4.216964822e-03f, 3.162277862e-03f, 2.371373819e-03f, 1.778279431e-03f, 1.333521446e-03f,
    1.000000047e-03f, 7.498941850e-04f, 5.623413017e-04f, 4.216965463e-04f, 3.162277862e-04f, 2.371373848e-04f, 1.778279402e-04f, 1.333521504e-04f};

__device__ __forceinline__ unsigned pk2(float lo, float hi) { f32x2 v = {lo, hi}; bf16x2_t b = __builtin_convertvector(v, bf16x2_t); return __builtin_bit_cast(unsigned, b); }
__device__ __forceinline__ float bflo(unsigned u) { return __uint_as_float(u << 16); }
__device__ __forceinline__ float bfhi(unsigned u) { return __uint_as_float(u & 0xffff0000u); }
__device__ __forceinline__ f32x4 bf4(u32x2 u) { return (f32x4){bflo(u.x), bfhi(u.x), bflo(u.y), bfhi(u.y)}; }
__device__ __forceinline__ u32x2 pk4(f32x4 v) { u32x2 r; r.x = pk2(v.x, v.y); r.y = pk2(v.z, v.w); return r; }
__device__ __forceinline__ float fexp(float x) { return __builtin_amdgcn_exp2f(x * 1.4426950408889634f); }
__device__ __forceinline__ float fsigmoid(float x) { return __builtin_amdgcn_rcpf(1.0f + fexp(-x)); }
__device__ __forceinline__ float ftanh(float x) { return 1.0f - 2.0f * __builtin_amdgcn_rcpf(fexp(2.0f * x) + 1.0f); }
template <int CTRL> __device__ __forceinline__ float dppf(float v) { return __int_as_float(__builtin_amdgcn_update_dpp(0, __float_as_int(v), CTRL, 0xf, 0xf, true)); }
__device__ __forceinline__ float red8(float v) { v += dppf<0xB1>(v); v += dppf<0x4E>(v); v += dppf<0x141>(v); return v; }
__device__ __forceinline__ float red16(float v) { v = red8(v); v += dppf<0x140>(v); return v; }
__device__ __forceinline__ float wave_sum(float v) {
    v = red16(v);
    const int i = __float_as_int(v);
    const float a0 = __int_as_float(__builtin_amdgcn_readlane(i, 0)), a1 = __int_as_float(__builtin_amdgcn_readlane(i, 16)), a2 = __int_as_float(__builtin_amdgcn_readlane(i, 32)), a3 = __int_as_float(__builtin_amdgcn_readlane(i, 48));
    return (a0 + a1) + (a2 + a3);
}
__device__ __forceinline__ float xhalf_sum(float v);
__device__ __forceinline__ float fq_sum(float v) {
    v += __int_as_float(__builtin_amdgcn_ds_swizzle(__float_as_int(v), 0x401F));
    auto rr = __builtin_amdgcn_permlane32_swap(__float_as_uint(v), __float_as_uint(v), false, false); return __uint_as_float(rr[0]) + __uint_as_float(rr[1]);
}
__device__ __forceinline__ float max3f(float a, float b, float c) { float r; asm("v_max3_f32 %0, %1, %2, %3" : "=v"(r) : "v"(a), "v"(b), "v"(c)); return r; }
__device__ __forceinline__ float xhalf_max(float v) { auto rr = __builtin_amdgcn_permlane32_swap(__float_as_uint(v), __float_as_uint(v), false, false); return fmaxf(__uint_as_float(rr[0]), __uint_as_float(rr[1])); }
__device__ __forceinline__ float xhalf_sum(float v) { auto rr = __builtin_amdgcn_permlane32_swap(__float_as_uint(v), __float_as_uint(v), false, false); return __uint_as_float(rr[0]) + __uint_as_float(rr[1]); }

__device__ __forceinline__ void lds_barrier() { asm volatile("s_waitcnt lgkmcnt(0)" ::: "memory"); __builtin_amdgcn_s_barrier(); asm volatile("" ::: "memory"); }
__device__ __forceinline__ u32x4 gload16_asm(const void* p) { u32x4 r; asm volatile("global_load_dwordx4 %0, %1, off" : "=v"(r) : "v"(p) : "memory"); return r; }
struct Args { const float* in[33]; float* out; unsigned char* ws; int ph_lo, ph_hi; };

__device__ __forceinline__ void row_rstd8(const float* rsq, int row0, int fq, float (&rs)[8]) {
    if (!rsq) {
#pragma unroll
        for (int i = 0; i < 8; ++i) rs[i] = 1.f;
        return;
    }
    f32x4 p[8];
#pragma unroll
    for (int i = 0; i < 8; ++i) p[i] = *(const f32x4*)(rsq + (size_t)(row0 + (i >> 2) * 128 + (i & 3) * 16) * 16 + 4 * fq);
    asm volatile("" ::: "memory");
#pragma unroll
    for (int i = 0; i < 8; ++i) rs[i] = rsqrtf(fq_sum((p[i].x + p[i].y) + (p[i].z + p[i].w)) * (1.f / DM) + 1e-6f);
}
struct EpiSwiGLU {
    static constexpr bool PERM = true, AFTER_DRAIN = false;
    bf16* O;
    const float* rsq;
    __device__ __forceinline__ void operator()(const pg8::f32x4 (&acc)[2][2][4][2], const pg8::Unit& u, int wr, int wc, int fr, int fq) const {
        int oz; asm volatile("v_mov_b32 %0, 0" : "=v"(oz));
        const int row0 = u.pm * 256 + wr * 64 + fr + oz, col0 = u.pn * 128 + wc * 32 + 8 * fq;
        float rs8[8]; row_rstd8(rsq, row0, fq, rs8);
#pragma unroll
        for (int ai = 0; ai < 2; ++ai)
#pragma unroll
            for (int m = 0; m < 4; ++m) {
                bf16* p = O + (size_t)(row0 + ai * 128 + m * 16) * DFF + col0;
                const float r = rs8[ai * 4 + m];
                const f32x2 rr2 = {r * r, r * r}, nl2 = {-1.4426950408889634f * r, -1.4426950408889634f * r};
                unsigned w[4];
#pragma unroll
                for (int n = 0; n < 2; ++n)
#pragma unroll
                    for (int e = 0; e < 4; e += 2) {
                        const f32x2 ag = {acc[ai][0][m][n][e], acc[ai][0][m][n][e + 1]}, au = {acc[ai][1][m][n][e], acc[ai][1][m][n][e + 1]};
                        const f32x2 x = ag * nl2;
                        f32x2 d = {__builtin_amdgcn_exp2f(x.x), __builtin_amdgcn_exp2f(x.y)};
                        d = d + 1.0f;
                        const f32x2 rc = {__builtin_amdgcn_rcpf(d.x), __builtin_amdgcn_rcpf(d.y)};
                        const f32x2 hh = (ag * au) * (rc * rr2);
                        w[2 * n + (e >> 1)] = pk2(hh.x, hh.y);
                    }
                *(u32x4*)p = (u32x4){w[0], w[1], w[2], w[3]};
            }
    }
};
struct EpiResid {
    static constexpr bool PERM = false, AFTER_DRAIN = false;
    const float* base; float* out; const float* gn; bf16* XN; float* rsq; float scale, pad_;
    __device__ __forceinline__ void operator()(const pg8::f32x4 (&acc)[2][2][4][2], const pg8::Unit& u, int wr, int wc, int fr, int fq) const {
        int oz; asm volatile("v_mov_b32 %0, 0" : "=v"(oz));
        const int row0 = u.pm * 256 + wr * 64 + fr + oz, col0 = u.pn * 256 + wc * 32 + 4 * fq;
        const float* gp = gn ? gn : base;
        f32x4 g4[2][2];
#pragma unroll
        for (int bj = 0; bj < 2; ++bj)
#pragma unroll
            for (int n = 0; n < 2; ++n) g4[bj][n] = *(const f32x4*)(gp + col0 + bj * 128 + n * 16);
#pragma unroll
        for (int ai = 0; ai < 2; ++ai) {
            f32x4 bv[4][2][2];
#pragma unroll
            for (int m = 0; m < 4; ++m)
#pragma unroll
                for (int bj = 0; bj < 2; ++bj)
#pragma unroll
                    for (int n = 0; n < 2; ++n) bv[m][bj][n] = *(const f32x4*)(base + (size_t)(row0 + ai * 128 + m * 16) * DM + col0 + bj * 128 + n * 16);
            asm volatile("" ::: "memory");
#pragma unroll
            for (int m = 0; m < 4; ++m) {
                const int row = row0 + ai * 128 + m * 16;
                const size_t ro = (size_t)row * DM + col0;
                float ss = 0.f;
#pragma unroll
                for (int bj = 0; bj < 2; ++bj)
#pragma unroll
                    for (int n = 0; n < 2; ++n) {
                        const size_t off = ro + bj * 128 + n * 16;
                        f32x4 a; a.x = acc[ai][bj][m][n][0]; a.y = acc[ai][bj][m][n][1]; a.z = acc[ai][bj][m][n][2]; a.w = acc[ai][bj][m][n][3];
                        const f32x4 v = bv[m][bj][n] + a * scale;
                        *(f32x4*)(out + off) = v;
                        if (gn) { *(u32x2*)(XN + off) = pk4(v * g4[bj][n]); ss += (v.x * v.x + v.y * v.y) + (v.z * v.z + v.w * v.w); }
                    }
                if (gn) { ss = fq_sum(ss); if (fq == 0) rsq[(size_t)row * 16 + u.pn * 4 + wc] = ss; }
            }
        }
    }
};
struct EpiStore {
    static constexpr bool PERM = true, AFTER_DRAIN = false;
    bf16* O; int ldc; const float* rsq;
    __device__ __forceinline__ void operator()(const pg8::f32x4 (&acc)[2][2][4][2], const pg8::Unit& u, int wr, int wc, int fr, int fq) const {
        int oz; asm volatile("v_mov_b32 %0, 0" : "=v"(oz));
        const int row0 = u.pm * 256 + wr * 64 + fr + oz, col0 = u.pn * 256 + wc * 32 + 8 * fq;
        float rs8[8]; row_rstd8(rsq, row0, fq, rs8);
#pragma unroll
        for (int ai = 0; ai < 2; ++ai)
#pragma unroll
            for (int m = 0; m < 4; ++m) {
                bf16* p = O + (size_t)(row0 + ai * 128 + m * 16) * ldc + col0;
                const float r = rs8[ai * 4 + m];
#pragma unroll
                for (int bj = 0; bj < 2; ++bj) {
                    u32x4 w; w.x = pk2(acc[ai][bj][m][0][0] * r, acc[ai][bj][m][0][1] * r); w.y = pk2(acc[ai][bj][m][0][2] * r, acc[ai][bj][m][0][3] * r);
                    w.z = pk2(acc[ai][bj][m][1][0] * r, acc[ai][bj][m][1][1] * r); w.w = pk2(acc[ai][bj][m][1][2] * r, acc[ai][bj][m][1][3] * r);
                    *(u32x4*)(p + bj * 128) = w;
                }
            }
    }
};
__device__ __forceinline__ float decay_f(float x) {
    const float y = -x, sp = fmaxf(y, 0.f) + __builtin_amdgcn_logf(1.0f + fexp(-fabsf(y))) * 0.6931471805599453f;
    return fexp(-fexp(-sp - 0.5f));
}

struct EpiLowRank {
    static constexpr bool PERM = true, AFTER_DRAIN = false;
    float* W; bf16* Aa; bf16* G; const float* w0; const float* a0;
    __device__ __forceinline__ void operator()(const pg8::f32x4 (&acc)[2][2][4][2], const pg8::Unit& u, int wr, int wc, int fr, int fq) const {
        const int region = u.pn >> 1;
        int oz; asm volatile("v_mov_b32 %0, 0" : "=v"(oz));
        const int row0 = u.pm * 256 + wr * 64 + fr + oz, col0 = (u.pn & 1) * 256 + wc * 32 + 8 * fq;
        bf16* OB = region == 1 ? Aa : G;
        const float* bp = region == 0 ? w0 : a0;
#pragma unroll
        for (int bj = 0; bj < 2; ++bj) {
            f32x4 b0 = {0.f, 0.f, 0.f, 0.f}, b1 = b0;
            if (region < 2) { b0 = *(const f32x4*)(bp + col0 + bj * 128); b1 = *(const f32x4*)(bp + col0 + bj * 128 + 4); }
#pragma unroll
            for (int ai = 0; ai < 2; ++ai)
#pragma unroll
                for (int m = 0; m < 4; ++m) {
                    const size_t off = (size_t)(row0 + ai * 128 + m * 16) * 512 + col0 + bj * 128;
                    f32x4 v0 = (f32x4){acc[ai][bj][m][0][0], acc[ai][bj][m][0][1], acc[ai][bj][m][0][2], acc[ai][bj][m][0][3]} + b0;
                    f32x4 v1 = (f32x4){acc[ai][bj][m][1][0], acc[ai][bj][m][1][1], acc[ai][bj][m][1][2], acc[ai][bj][m][1][3]} + b1;
                    if (region == 0) {
                        *(f32x4*)(W + off) = (f32x4){decay_f(v0.x), decay_f(v0.y), decay_f(v0.z), decay_f(v0.w)};
                        *(f32x4*)(W + off + 4) = (f32x4){decay_f(v1.x), decay_f(v1.y), decay_f(v1.z), decay_f(v1.w)};
                    } else {
                        if (region == 1) { v0 = (f32x4){fsigmoid(v0.x), fsigmoid(v0.y), fsigmoid(v0.z), fsigmoid(v0.w)}; v1 = (f32x4){fsigmoid(v1.x), fsigmoid(v1.y), fsigmoid(v1.z), fsigmoid(v1.w)}; }
                        u32x4 w; w.x = pk2(v0.x, v0.y); w.y = pk2(v0.z, v0.w); w.z = pk2(v1.x, v1.y); w.w = pk2(v1.z, v1.w);
                        *(u32x4*)(OB + off) = w;
                    }
                    asm volatile("" ::: "memory");
                }
        }
    }
};

template <class Epi> __device__ __forceinline__ void run_gemm(LAS unsigned char* lds, const bf16* A, const bf16* Bt, int N, int K, const Epi& E) {
    asm volatile("" : "+s"(N), "+s"(K));
    pg8::Gemm g{A, Bt, T, N, K}; pg8::StaticOrder S; S.init(T, N, (int)gridDim.x, (int)blockIdx.x);
    pg8::gemm_phase<Epi, pg8::StaticOrder, true, true>(lds, g, S, E);
}

__device__ __forceinline__ void transpose_item(const float* W, int K, int N, bf16* WT, int mode, LAS float* scr, int item, int lane) {
    const int nblk = N / 32, kb = item / nblk, nb = item % nblk, k0 = 64 * kb, n0 = 32 * nb;
    int drow0 = n0; if (mode) drow0 = 256 * (n0 >> 7) + (n0 & 127) + (mode == 2 ? 128 : 0);
    float tv[32];
#pragma unroll
    for (int i = 0; i < 32; ++i) tv[i] = W[(size_t)(k0 + 2 * i + (lane >> 5)) * N + n0 + (lane & 31)];
#pragma unroll
    for (int i = 0; i < 32; ++i) scr[(2 * i + (lane >> 5)) * 33 + (lane & 31)] = tv[i];
    asm volatile("s_waitcnt lgkmcnt(0)" ::: "memory");
    const int c = lane & 7;
#pragma unroll
    for (int j = 0; j < 4; ++j) { const int n = (lane >> 3) + 8 * j; const LAS float* s = scr + (8 * c) * 33 + n;
        u32x4 o; o.x = pk2(s[0 * 33], s[1 * 33]); o.y = pk2(s[2 * 33], s[3 * 33]); o.z = pk2(s[4 * 33], s[5 * 33]); o.w = pk2(s[6 * 33], s[7 * 33]);
        *(u32x4*)(WT + (size_t)(drow0 + n) * K + k0 + 8 * c) = o; }
    asm volatile("s_waitcnt lgkmcnt(0)" ::: "memory");
}

__device__ __forceinline__ void transpose_load(const float* W, int K, int N, int item, int lane, float (&tv)[32]) {
    const int nblk = N / 32, kb = item / nblk, nb = item % nblk, k0 = 64 * kb, n0 = 32 * nb;
#pragma unroll
    for (int i = 0; i < 32; ++i) tv[i] = W[(size_t)(k0 + 2 * i + (lane >> 5)) * N + n0 + (lane & 31)];
}
__device__ __forceinline__ void transpose_store(int K, int N, bf16* WT, int mode, LAS float* scr, int item, int lane, const float (&tv)[32]) {
    const int nblk = N / 32, kb = item / nblk, nb = item % nblk, k0 = 64 * kb, n0 = 32 * nb;
    int drow0 = n0; if (mode) drow0 = 256 * (n0 >> 7) + (n0 & 127) + (mode == 2 ? 128 : 0);
#pragma unroll
    for (int i = 0; i < 32; ++i) scr[(2 * i + (lane >> 5)) * 33 + (lane & 31)] = tv[i];
    asm volatile("s_waitcnt lgkmcnt(0)" ::: "memory");
    const int c = lane & 7;
#pragma unroll
    for (int j = 0; j < 4; ++j) { const int n = (lane >> 3) + 8 * j; const LAS float* sp = scr + (8 * c) * 33 + n;
        u32x4 o; o.x = pk2(sp[0 * 33], sp[1 * 33]); o.y = pk2(sp[2 * 33], sp[3 * 33]); o.z = pk2(sp[4 * 33], sp[5 * 33]); o.w = pk2(sp[6 * 33], sp[7 * 33]);
        *(u32x4*)(WT + (size_t)(drow0 + n) * K + k0 + 8 * c) = o; }
    asm volatile("s_waitcnt lgkmcnt(0)" ::: "memory");
}
constexpr int DI_GU = 16 * 88, DI_D = 44 * 32, DI_SQ = 16 * 32, DI_CIN = 16 * 96;
constexpr int DEFER_ITEMS = 6 * DI_GU + 3 * DI_D + DI_SQ + DI_CIN + DI_SQ;
struct DeferItem { const float* W; bf16* WT; int K, N, mode, item; };
__device__ __forceinline__ DeferItem defer_decode(const Args& a, int it) {
    DeferItem d; unsigned char* ws = a.ws; int r = it;
    if (r < 6 * DI_GU) { const int f = 1 + r / (2 * DI_GU), which = (r / DI_GU) & 1;
        d.W = (which ? a.in[3] : a.in[2]) + (size_t)f * DM * DFF; d.WT = (bf16*)(ws + WS_WGU + f * WGU_STRIDE); d.K = DM; d.N = DFF; d.mode = 1 + which; d.item = r % DI_GU; return d; }
    r -= 6 * DI_GU;
    if (r < 3 * DI_D) { const int f = 1 + r / DI_D; d.W = a.in[4] + (size_t)f * DFF * DM; d.WT = (bf16*)(ws + WS_WD + f * WD_STRIDE); d.K = DFF; d.N = DM; d.mode = 0; d.item = r % DI_D; return d; }
    r -= 3 * DI_D;
    if (r < DI_SQ) { d.W = a.in[23]; d.WT = (bf16*)(ws + WS_WEOUT); d.K = DM; d.N = DM; d.mode = 0; d.item = r; return d; } r -= DI_SQ;
    if (r < DI_CIN) { d.W = a.in[24]; d.WT = (bf16*)(ws + WS_WCIN); d.K = DM; d.N = Z3W; d.mode = 0; d.item = r; return d; } r -= DI_CIN;
    d.W = a.in[32]; d.WT = (bf16*)(ws + WS_WCOUT); d.K = DM; d.N = DM; d.mode = 0; d.item = r; return d;
}

__device__ __forceinline__ void rmsnorm_phase(const float* X, const float* g, bf16* XN, int gw, int NGW, int lane) {
    f32x4 gv[4];
#pragma unroll
    for (int j = 0; j < 4; ++j) gv[j] = *(const f32x4*)(g + 4 * lane + 256 * j);
#pragma unroll 4
    for (int m = gw; m < T; m += NGW) {
        const f32x4* xr = (const f32x4*)(X + (size_t)m * DM) + lane;
        f32x4 v[4]; float s = 0.f;
#pragma unroll
        for (int j = 0; j < 4; ++j) { v[j] = xr[64 * j]; s += (v[j].x * v[j].x + v[j].y * v[j].y) + (v[j].z * v[j].z + v[j].w * v[j].w); }
        const float rstd = rsqrtf(wave_sum(s) * (1.f / DM) + 1e-6f);
        u32x2* o8 = (u32x2*)(XN + (size_t)m * DM) + lane;
#pragma unroll
        for (int j = 0; j < 4; ++j) o8[64 * j] = pk4(v[j] * rstd * gv[j]);
    }
}

__device__ __forceinline__ void prologue_phase(const Args& a, LAS unsigned char* lds, int tid, int lane, int wave) {
    unsigned char* ws = a.ws;
    LAS float* scr = (LAS float*)(lds + wave * 16384);
    const int gw = blockIdx.x * NWAVES + wave, NGW = gridDim.x * NWAVES;
    constexpr int I_GU = 16 * 88, I_D = 44 * 32, I_AIN = 16 * 88;
    constexpr int NITEMS = 2 * I_GU + I_D + I_AIN;
    for (int it = gw; it < NITEMS; it += NGW) {
        int r = it;
        if (r < 2 * I_GU) { const int which = r / I_GU, i = r % I_GU; transpose_item(which ? a.in[3] : a.in[2], DM, DFF, (bf16*)(ws + WS_WGU), 1 + which, scr, i, lane); continue; }
        r -= 2 * I_GU;
        if (r < I_D) { transpose_item(a.in[4], DFF, DM, (bf16*)(ws + WS_WD), 0, scr, r, lane); continue; }
        r -= I_D;
        transpose_item(a.in[6], DM, ZW, (bf16*)(ws + WS_WAIN), 0, scr, r, lane);
    }
    {
        bf16* BD = (bf16*)(ws + WS_WBD);
        const int gt = blockIdx.x * NTHR + tid, NGT = gridDim.x * NTHR;
        for (int i = gt; i < 1536 * 256; i += NGT) {
            const int n = i >> 8, k = i & 255; float v = 0.f;
            if (n < 512) { if (k < 64) v = a.in[9][k * 512 + n]; }
            else if (n < 1024) { if (k >= 64 && k < 128) v = a.in[11][(k - 64) * 512 + (n - 512)]; }
            else { if (k >= 128) v = a.in[12][(k - 128) * 512 + (n - 1024)]; }
            BD[i] = (bf16)(pk2(v, 0.f) & 0xffffu);
        }
        float* COS = (float*)(ws + WS_ROPE); float* SIN = COS + SEQ * 32;
        for (int i = gt; i < SEQ * 32; i += NGT) {
            const int s = i >> 5, j = i & 31;
            const float ang = (float)s * ROPE_INV[j];
            double rev = (double)ang * 0.15915494309189535; rev -= floor(rev);
            COS[i] = __builtin_amdgcn_cosf((float)rev); SIN[i] = __builtin_amdgcn_sinf((float)rev);
        }
        if (blockIdx.x == 0 && wave == 0) {
            const float s1 = wave_sum(a.in[27][lane] * a.in[28][lane]), s2 = wave_sum(a.in[29][lane] * a.in[30][lane]);
            if (lane == 0) *(float*)(ws + WS_LAM) = expf(s1) - expf(s2) + LAM_INIT;
        }
    }
    rmsnorm_phase(a.in[0], a.in[1], (bf16*)(ws + WS_XN), gw, NGW, lane);
}

__device__ __forceinline__ void e1_phase(const bf16* Z, const float* mu, bf16* LR, int tid) {
    const int seg = tid & 31, col = 1536 + 8 * seg;
    float muv[8];
#pragma unroll
    for (int e = 0; e < 8; ++e) muv[e] = mu[col + e];
#pragma unroll 2
    for (int it = blockIdx.x; it < T / 16; it += gridDim.x) {
        const int m = it * 16 + (tid >> 5), s = m & (SEQ - 1);
        const u32x4 zc = *(const u32x4*)(Z + (size_t)m * ZW + col);
        u32x4 zp = {0u, 0u, 0u, 0u}; if (s) zp = *(const u32x4*)(Z + (size_t)(m - 1) * ZW + col);
        float v[8];
#pragma unroll
        for (int e = 0; e < 4; ++e) { const float c0 = bflo(zc[e]), c1 = bfhi(zc[e]), p0 = bflo(zp[e]), p1 = bfhi(zp[e]);
            v[2 * e] = c0 + (p0 - c0) * muv[2 * e]; v[2 * e + 1] = c1 + (p1 - c1) * muv[2 * e + 1]; }
        if (seg < 8) {
#pragma unroll
            for (int e = 0; e < 8; ++e) v[e] = ftanh(v[e]);
        } else if (seg >= 16) {
#pragma unroll
            for (int e = 0; e < 8; ++e) v[e] = fsigmoid(v[e]);
        }
        u32x4 w; w.x = pk2(v[0], v[1]); w.y = pk2(v[2], v[3]); w.z = pk2(v[4], v[5]); w.w = pk2(v[6], v[7]);
        *(u32x4*)(LR + (size_t)m * 256 + 8 * seg) = w;
    }
}
__device__ __forceinline__ void e2_phase(const Args& a, const bf16* Z, bf16* Aa, float* W, bf16* KK, float* BON, int gw, int NGW, int lane) {
    const float* mu = a.in[7];
    const int half = gw & 1, c = half * 256 + 4 * lane, h = c >> 6;
    const f32x4 mur = *(const f32x4*)(mu + c), muk = *(const f32x4*)(mu + 512 + c), kkw = *(const f32x4*)(a.in[13] + c), kaw = *(const f32x4*)(a.in[14] + c), rkw = *(const f32x4*)(a.in[15] + c), a0w = *(const f32x4*)(a.in[10] + c), w0w = *(const f32x4*)(a.in[8] + c);
    const int MS = NGW >> 1;
    for (int mb = gw >> 1; mb < T; mb += 4 * MS) {
        u32x2 zr[4], zk[4], zrp[4], zkp[4], za[4];
#pragma unroll
        for (int i = 0; i < 4; ++i) {
            const int m = mb + i * MS; const bool ok = m < T; const int mm = ok ? m : 0, s = mm & (SEQ - 1);
            const bf16* zp = Z + (size_t)mm * ZW + c;
            zr[i] = *(const u32x2*)zp; zk[i] = *(const u32x2*)(zp + 512); za[i] = *(const u32x2*)(Aa + (size_t)mm * 512 + c);
            const bf16* zq = s ? zp - ZW : zp;
            zrp[i] = *(const u32x2*)zq; zkp[i] = *(const u32x2*)(zq + 512);
            if (!s) { zrp[i] = (u32x2){0u, 0u}; zkp[i] = zrp[i]; }
        }
#pragma unroll
        for (int i = 0; i < 4; ++i) {
            const int m = mb + i * MS; if (m >= T) break;
            const f32x4 rc = bf4(zr[i]), kc = bf4(zk[i]), rp = bf4(zrp[i]), kp = bf4(zkp[i]), av = bf4(za[i]);
            const f32x4 r = rc + (rp - rc) * mur, k = kc + (kp - kc) * muk;
            const f32x4 kr = k * kkw;
            const float ss = red16((kr.x * kr.x + kr.y * kr.y) + (kr.z * kr.z + kr.w * kr.w));
            const float inv = 1.0f / fmaxf(sqrtf(ss), 1e-12f);
            const f32x4 kt = k * (1.0f + (av - 1.0f) * kaw);
            const f32x4 bb = r * kt * rkw;
            const float bon = red16((bb.x + bb.y) + (bb.z + bb.w));
            *(u32x2*)(KK + (size_t)m * 512 + c) = pk4(kr * inv);
            if ((lane & 15) == 0) BON[m * 8 + h] = bon;
        }
    }
}

constexpr int SCH = 32, SROW = 336;
__device__ __forceinline__ void scan_phase(const Args& a, LAS unsigned char* lds, const bf16* Z, const float* W, const bf16* Aa, const bf16* KK, float* Y, int tid, int lane, int wave) {
    const float* mu = a.in[7];
    LAS float* buf = (LAS float*)lds;
    const int lt = tid & 255, step0 = lt >> 4, seg = lt & 15;
    const bool loader = wave >= 4;
    for (int u = blockIdx.x; u < 256; u += gridDim.x) {
        const int bh = (u & 7) + 8 * (u >> 5), rg = (u >> 3) & 3, b = bh >> 3, h = bh & 7;
        const int c = h * 64 + 4 * seg;
        const int cv = h * 64 + rg * 16 + 4 * (seg & 3);
        const f32x4 mur = *(const f32x4*)(mu + c), muk = *(const f32x4*)(mu + 512 + c), muv = *(const f32x4*)(mu + 1024 + cv), kaw = *(const f32x4*)(a.in[14] + c);
        const size_t m0 = (size_t)b * SEQ;
        u32x2 zr[2], zrp[2], zk[2], zkp[2], zv[2], zvp[2], kk4[2], a4[2]; f32x4 w4[2];
#pragma unroll
        for (int i = 0; i < 2; ++i) { zv[i] = (u32x2){0u, 0u}; zvp[i] = zv[i]; }
#define SCAN_LOAD1(t0, i) do { const int t_ = (t0) + step0 + 16 * (i); const size_t m_ = m0 + t_; const bf16* zp_ = Z + m_ * ZW; \
            zr[i] = *(const u32x2*)(zp_ + c); zk[i] = *(const u32x2*)(zp_ + 512 + c); if (seg < 4) zv[i] = *(const u32x2*)(zp_ + 1024 + cv); \
            if (t_ > 0) { zrp[i] = *(const u32x2*)(zp_ - ZW + c); zkp[i] = *(const u32x2*)(zp_ - ZW + 512 + c); if (seg < 4) zvp[i] = *(const u32x2*)(zp_ - ZW + 1024 + cv); } \
            else { zrp[i] = (u32x2){0u, 0u}; zkp[i] = zrp[i]; zvp[i] = zrp[i]; } \
            kk4[i] = *(const u32x2*)(KK + m_ * 512 + c); a4[i] = *(const u32x2*)(Aa + m_ * 512 + c); w4[i] = *(const f32x4*)(W + m_ * 512 + c); } while (0)
#define SCAN_STORE1(bi, i) do { LAS float* d_ = buf + (bi) * (SCH * SROW) + (step0 + 16 * (i)) * SROW + 4 * seg; \
            const f32x4 rc_ = bf4(zr[i]), rp_ = bf4(zrp[i]), kc_ = bf4(zk[i]), kp_ = bf4(zkp[i]), av_ = bf4(a4[i]), kkv_ = bf4(kk4[i]), wd_ = w4[i]; \
            const f32x4 r_ = rc_ + (rp_ - rc_) * mur, k_ = kc_ + (kp_ - kc_) * muk; \
            *(LAS f32x4*)(d_) = wd_; *(LAS f32x4*)(d_ + 64) = k_ * (1.0f + (av_ - 1.0f) * kaw); *(LAS f32x4*)(d_ + 128) = -kkv_; *(LAS f32x4*)(d_ + 192) = kkv_ * av_; *(LAS f32x4*)(d_ + 256) = r_; \
            if (seg < 4) { const f32x4 vc_ = bf4(zv[i]), vp_ = bf4(zvp[i]); *(LAS f32x4*)(d_ + 320) = vc_ + (vp_ - vc_) * muv; } } while (0)
#define SCAN_LOAD(t0) do { SCAN_LOAD1(t0, 0); SCAN_LOAD1(t0, 1); } while (0)
#define SCAN_STORE(bi) do { SCAN_STORE1(bi, 0); SCAN_STORE1(bi, 1); } while (0)
        if (loader) { SCAN_LOAD(0); SCAN_STORE(0); SCAN_LOAD(SCH); }
        lds_barrier();
        f32x2 S01 = {0.f, 0.f}, S23 = {0.f, 0.f};
        const bool dfirst = (u == (int)blockIdx.x);
        const int NL = gridDim.x * 4, gl = blockIdx.x * 4 + (wave - 4);
        LAS float* dscr = (LAS float*)(lds + 90112 + (wave & 3) * 8448);
        float dtv[32];
#pragma unroll
        for (int i = 0; i < 32; ++i) dtv[i] = 0.f;
        const bool consumer = wave < 4;
        const int j = lane & 15, ri = 4 * wave + (lane >> 4);
        float* yp = Y + m0 * 512 + h * 64 + rg * 16 + ri;
        for (int ch = 0; ch < SEQ / SCH; ++ch) {
            if (loader) {
                if (ch + 1 < SEQ / SCH) SCAN_STORE((ch + 1) & 1);
                if (ch + 2 < SEQ / SCH) SCAN_LOAD((ch + 2) * SCH);
                if (dfirst) {
                    const int dit = gl + (ch >> 3) * NL;
                    if (dit < DEFER_ITEMS) {
                        if ((ch & 7) == 1) { const DeferItem d = defer_decode(a, dit); transpose_load(d.W, d.K, d.N, d.item, lane, dtv); }
                        else if ((ch & 7) == 2) { const DeferItem d = defer_decode(a, dit); transpose_store(d.K, d.N, d.WT, d.mode, dscr, d.item, lane, dtv); }
                    }
                }
            }
            if (consumer) {
                const LAS float* sb = buf + (ch & 1) * (SCH * SROW) + 4 * j;
                const LAS float* vb = buf + (ch & 1) * (SCH * SROW) + 320 + ri;
                f32x4 pw[3], pk[3], pa[3], pb[3], pr[3]; float pv[3];
#pragma unroll
                for (int i = 0; i < 2; ++i) { const LAS float* p = sb + i * SROW;
                    pw[i] = *(const LAS f32x4*)p; pk[i] = *(const LAS f32x4*)(p + 64); pa[i] = *(const LAS f32x4*)(p + 128); pb[i] = *(const LAS f32x4*)(p + 192); pr[i] = *(const LAS f32x4*)(p + 256); pv[i] = vb[i * SROW]; }
                float ykA = 0.f, ykB = 0.f, yd = 0.f;
#pragma unroll
                for (int q = 0; q < SCH; ++q) {
                    const f32x4 wv = pw[q % 3], kv = pk[q % 3], av = pa[q % 3], bv = pb[q % 3], rv = pr[q % 3]; const float vv = pv[q % 3];
                    if (q + 2 < SCH) {
                        const LAS float* p = sb + (q + 2) * SROW; const int i = (q + 2) % 3;
                        pw[i] = *(const LAS f32x4*)p; pk[i] = *(const LAS f32x4*)(p + 64); pa[i] = *(const LAS f32x4*)(p + 128); pb[i] = *(const LAS f32x4*)(p + 192); pr[i] = *(const LAS f32x4*)(p + 256);
                        pv[i] = vb[(q + 2) * SROW];
                    }
                    f32x2 t2 = S01 * (f32x2){av.x, av.y}; t2 = S23 * (f32x2){av.z, av.w} + t2;
                    float sa = t2.x + t2.y;
                    sa += dppf<0xB1>(sa); yd += dppf<0xB1>(yd);
                    sa += dppf<0x4E>(sa); yd += dppf<0x4E>(yd);
                    sa += dppf<0x141>(sa); yd += dppf<0x141>(yd);
                    sa += dppf<0x140>(sa); yd += dppf<0x140>(yd);
                    if (q > 0) { if (q <= 16) ykA = (j == q - 1) ? yd : ykA; else ykB = (j == q - 17) ? yd : ykB; }
                    const f32x2 u01 = S01 * (f32x2){wv.x, wv.y} + (f32x2){kv.x, kv.y} * vv, u23 = S23 * (f32x2){wv.z, wv.w} + (f32x2){kv.z, kv.w} * vv;
                    S01 = u01 + (f32x2){bv.x, bv.y} * sa; S23 = u23 + (f32x2){bv.z, bv.w} * sa;
                    f32x2 y2 = S01 * (f32x2){rv.x, rv.y}; y2 = S23 * (f32x2){rv.z, rv.w} + y2;
                    yd = y2.x + y2.y;
                }
                yd = red16(yd); ykB = (j == 15) ? yd : ykB;
                yp[(size_t)(ch * SCH + j) * 512] = ykA;
                yp[(size_t)(ch * SCH + 16 + j) * 512] = ykB;
            }
            lds_barrier();
        }
        if (loader && dfirst) {
            for (int dit = gl + (SEQ / SCH / 8) * NL; dit < DEFER_ITEMS; dit += NL) { const DeferItem d = defer_decode(a, dit); transpose_load(d.W, d.K, d.N, d.item, lane, dtv); transpose_store(d.K, d.N, d.WT, d.mode, dscr, d.item, lane, dtv); }
        }
#undef SCAN_LOAD
#undef SCAN_STORE
#undef SCAN_LOAD1
#undef SCAN_STORE1
    }
}

__device__ __forceinline__ void e3_phase(const Args& a, LAS unsigned char* lds, const bf16* Z, const float* Y, const float* BON, const bf16* G, bf16* YC, int tid, int lane, int wave) {
    const int gw = blockIdx.x * NWAVES + wave, NGW = gridDim.x * NWAVES;
    {
        const int half = gw & 1, c = half * 256 + 4 * lane, h = c >> 6;
        const f32x4 muv = *(const f32x4*)(a.in[7] + 1024 + c), lw = *(const f32x4*)(a.in[16] + c), lb = *(const f32x4*)(a.in[17] + c);
        const int MS = NGW >> 1;
        for (int mb = gw >> 1; mb < T; mb += 4 * MS) {
            f32x4 yv[4]; u32x2 zv[4], zvp[4], gv[4]; float bn[4];
#pragma unroll
            for (int i = 0; i < 4; ++i) {
                const int m = mb + i * MS; const bool ok = m < T; const int mm = ok ? m : 0, s = mm & (SEQ - 1);
                yv[i] = *(const f32x4*)(Y + (size_t)mm * 512 + c);
                const bf16* zp = Z + (size_t)mm * ZW + 1024 + c;
                zv[i] = *(const u32x2*)zp; zvp[i] = *(const u32x2*)(s ? zp - ZW : zp); if (!s) zvp[i] = (u32x2){0u, 0u};
                gv[i] = *(const u32x2*)(G + (size_t)mm * 512 + c); bn[i] = BON[mm * 8 + h];
            }
#pragma unroll
            for (int i = 0; i < 4; ++i) {
                const int m = mb + i * MS; if (m >= T) break;
                const f32x4 y = yv[i], vc = bf4(zv[i]), vp = bf4(zvp[i]), g = bf4(gv[i]);
                const float mean = red16((y.x + y.y) + (y.z + y.w)) * (1.f / 64.f);
                const f32x4 d = y - mean;
                const float var = red16((d.x * d.x + d.y * d.y) + (d.z * d.z + d.w * d.w)) * (1.f / 64.f);
                const f32x4 yn = d * rsqrtf(var + 64e-5f) * lw + lb;
                const f32x4 v = vc + (vp - vc) * muv;
                *(u32x2*)(YC + (size_t)m * DM + c) = pk4((yn + v * bn[i]) * g);
            }
        }
    }
    {
        LAS float* gl = (LAS float*)lds;
        const int ch = tid;
        const int sr = tid >> 6, sseg = tid & 63;
        f32x4 gb1a = *(const f32x4*)(a.in[18] + 8 * sseg), gb1b = *(const f32x4*)(a.in[18] + 8 * sseg + 4), gb2a = *(const f32x4*)(a.in[18] + 512 + 8 * sseg), gb2b = *(const f32x4*)(a.in[18] + 512 + 8 * sseg + 4);
        const float dwb = a.in[20][ch];
        float dw[31];
#pragma unroll
        for (int j = 0; j < 31; ++j) dw[j] = a.in[19][j * 512 + ch];
        const f32x4 cw0 = *(const f32x4*)(a.in[21] + 4 * lane), cw1 = *(const f32x4*)(a.in[21] + 256 + 4 * lane), cb0 = *(const f32x4*)(a.in[22] + 4 * lane), cb1 = *(const f32x4*)(a.in[22] + 256 + 4 * lane);
        for (int tile = blockIdx.x; tile < T / 32; tile += gridDim.x) {
            const int m0 = tile * 32, s0 = m0 & (SEQ - 1);
            u32x4 r1[8], r2[8];
#pragma unroll
            for (int i = 0; i < 8; ++i) {
                const int tt = 8 * i + sr, s = s0 - 30 + tt; const bool ok = tt < 62 && s >= 0;
                const bf16* zp = Z + (size_t)(ok ? m0 - 30 + tt : m0) * ZW + 1792 + 8 * sseg;
                r1[i] = *(const u32x4*)zp; r2[i] = *(const u32x4*)(zp + 512);
            }
#pragma unroll
            for (int i = 0; i < 8; ++i) {
                const int tt = 8 * i + sr, s = s0 - 30 + tt;
                if (tt < 62) {
                    f32x4 o0, o1;
                    if (s >= 0) {
                        const f32x4 u1a = (f32x4){bflo(r1[i].x), bfhi(r1[i].x), bflo(r1[i].y), bfhi(r1[i].y)} + gb1a, u1b = (f32x4){bflo(r1[i].z), bfhi(r1[i].z), bflo(r1[i].w), bfhi(r1[i].w)} + gb1b;
                        const f32x4 u2a = (f32x4){bflo(r2[i].x), bfhi(r2[i].x), bflo(r2[i].y), bfhi(r2[i].y)} + gb2a, u2b = (f32x4){bflo(r2[i].z), bfhi(r2[i].z), bflo(r2[i].w), bfhi(r2[i].w)} + gb2b;
                        o0 = (f32x4){u1a.x * fsigmoid(u2a.x), u1a.y * fsigmoid(u2a.y), u1a.z * fsigmoid(u2a.z), u1a.w * fsigmoid(u2a.w)};
                        o1 = (f32x4){u1b.x * fsigmoid(u2b.x), u1b.y * fsigmoid(u2b.y), u1b.z * fsigmoid(u2b.z), u1b.w * fsigmoid(u2b.w)};
                    } else { o0 = (f32x4){0.f, 0.f, 0.f, 0.f}; o1 = o0; }
                    *(LAS f32x4*)(gl + tt * 512 + 8 * sseg) = o0; *(LAS f32x4*)(gl + tt * 512 + 8 * sseg + 4) = o1;
                }
            }
            __syncthreads();
            {
                float gv[62];
#pragma unroll
                for (int i = 0; i < 62; ++i) gv[i] = gl[i * 512 + ch];
#pragma unroll
                for (int t = 0; t < 32; ++t) {
                    float acc = dwb;
#pragma unroll
                    for (int j = 0; j < 31; ++j) acc += gv[t + j] * dw[j];
                    gl[t * 512 + ch] = acc;
                }
            }
            __syncthreads();
#pragma unroll
            for (int q = 0; q < 4; ++q) {
                const int t = 4 * wave + q;
                const f32x4 x0 = *(const LAS f32x4*)(gl + t * 512 + 4 * lane), x1 = *(const LAS f32x4*)(gl + t * 512 + 256 + 4 * lane);
                const float mean = wave_sum((x0.x + x0.y) + (x0.z + x0.w) + (x1.x + x1.y) + (x1.z + x1.w)) * (1.f / 512.f);
                const f32x4 d0 = x0 - mean, d1 = x1 - mean;
                const float var = wave_sum((d0.x * d0.x + d0.y * d0.y) + (d0.z * d0.z + d0.w * d0.w) + (d1.x * d1.x + d1.y * d1.y) + (d1.z * d1.z + d1.w * d1.w)) * (1.f / 512.f);
                const float rs = rsqrtf(var + 1e-5f);
                f32x4 y0 = d0 * rs * cw0 + cb0, y1 = d1 * rs * cw1 + cb1;
                y0.x *= fsigmoid(y0.x); y0.y *= fsigmoid(y0.y); y0.z *= fsigmoid(y0.z); y0.w *= fsigmoid(y0.w);
                y1.x *= fsigmoid(y1.x); y1.y *= fsigmoid(y1.y); y1.z *= fsigmoid(y1.z); y1.w *= fsigmoid(y1.w);
                bf16* o = YC + (size_t)(m0 + t) * DM + 512 + 4 * lane;
                *(u32x2*)o = pk4(y0); *(u32x2*)(o + 256) = pk4(y1);
            }
            __syncthreads();
        }
    }
}

__device__ __forceinline__ void qkrope_phase(const Args& a, LAS unsigned char* lds, const bf16* Z3, bf16* Qn, bf16* Kn, bf16* Vt, int tid, int lane, int wave) {
    const int gw = blockIdx.x * NWAVES + wave, NGW = gridDim.x * NWAVES;
    const float* COS = (const float*)(a.ws + WS_ROPE); const float* SIN = COS + SEQ * 32;
    {
        const int part = gw & 3, isk = part >> 1, grp = lane >> 3, j = lane & 7, gi = (part & 1) * 8 + grp, h = gi >> 1, c = gi & 1;
        const int col0 = isk * 1024 + gi * 64 + 4 * j;
        const float* nw = a.in[isk ? 26 : 25];
        const f32x4 n1 = *(const f32x4*)(nw + 4 * j), n2 = *(const f32x4*)(nw + 32 + 4 * j);
        const float sc = isk ? 1.0f : QSCALE;
        bf16* dstb = isk ? Kn : Qn;
        const int MS = NGW >> 2;
        for (int mb = gw >> 2; mb < T; mb += 4 * MS) {
            u32x2 z1[4], z2[4]; f32x4 csv[4], snv[4];
#pragma unroll
            for (int i = 0; i < 4; ++i) {
                const int m = mb + i * MS; const int mm = m < T ? m : 0, s = mm & (SEQ - 1);
                const bf16* zp = Z3 + (size_t)mm * Z3W + col0;
                z1[i] = *(const u32x2*)zp; z2[i] = *(const u32x2*)(zp + 32);
                csv[i] = *(const f32x4*)(COS + s * 32 + 4 * j); snv[i] = *(const f32x4*)(SIN + s * 32 + 4 * j);
            }
#pragma unroll
            for (int i = 0; i < 4; ++i) {
                const int m = mb + i * MS; if (m >= T) break;
                const int b = m >> 12, s = m & (SEQ - 1);
                f32x4 x1 = bf4(z1[i]), x2 = bf4(z2[i]);
                const float ss = red8((x1.x * x1.x + x1.y * x1.y) + (x1.z * x1.z + x1.w * x1.w) + (x2.x * x2.x + x2.y * x2.y) + (x2.z * x2.z + x2.w * x2.w));
                const float rs = rsqrtf(ss * (1.f / 64.f) + 1e-6f);
                x1 = x1 * rs * n1; x2 = x2 * rs * n2;
                const f32x4 o1 = (x1 * csv[i] - x2 * snv[i]) * sc, o2 = (x2 * csv[i] + x1 * snv[i]) * sc;
                bf16* d = dstb + ((size_t)(((b * 8 + h) * 2 + c)) * SEQ + s) * 64 + 4 * j;
                *(u32x2*)d = pk4(o1); *(u32x2*)(d + 32) = pk4(o2);
            }
        }
    }
    {
        LAS bf16* Vs = (LAS bf16*)lds;
        for (int it = blockIdx.x; it < 64 * 64; it += gridDim.x) {
            const int bh = it >> 6, tile = it & 63, b = bh >> 3, h = bh & 7;
            { const int tk = tid >> 3, seg = tid & 7;
              const bf16* src = Z3 + (size_t)(b * SEQ + 64 * tile + tk) * Z3W + 2048 + h * 128 + 16 * seg;
              const u32x4 v0 = *(const u32x4*)src, v1 = *(const u32x4*)(src + 8);
              *(LAS u32x4*)(Vs + tk * 136 + 16 * seg) = v0; *(LAS u32x4*)(Vs + tk * 136 + 16 * seg + 8) = v1; }
            __syncthreads();
            { const int dv = tid >> 2, qr = tid & 3; unsigned w[8];
#pragma unroll
              for (int p = 0; p < 16; p += 2) {
                  const int k0 = 16 * qr + 4 * (p >> 3) + (p & 3) + 8 * ((p & 7) >> 2), k1 = k0 + 1;
                  w[p >> 1] = (unsigned)Vs[k0 * 136 + dv] | ((unsigned)Vs[k1 * 136 + dv] << 16);
              }
              bf16* dst = Vt + ((size_t)bh * 128 + dv) * SEQ + 64 * tile + 16 * qr;
              *(u32x4*)dst = (u32x4){w[0], w[1], w[2], w[3]}; *(u32x4*)(dst + 8) = (u32x4){w[4], w[5], w[6], w[7]}; }
            __syncthreads();
        }
    }
}

constexpr int AT_KB = 9216, AT_VB = 18432, AT_BUF = AT_KB + AT_VB;
__device__ __forceinline__ void attn_phase(const Args& a, LAS unsigned char* lds, const bf16* Qn, const bf16* Kn, const bf16* Vt, bf16* O, float* stash, int tid, int lane, int wave) {
    const int n32 = lane & 31, hi = lane >> 5;
    const float lam = *(const float*)(a.ws + WS_LAM);
    const float* subn = a.in[31];
    if (wave < 4) __builtin_amdgcn_s_setprio(2);
    for (int u = blockIdx.x; u < 1024; u += gridDim.x) {
        const int ub = u & 255, bh = (ub & 7) + 8 * (ub >> 5), quad = (ub >> 3) & 3, rnd = u >> 8;
        const int qb = rnd == 0 ? quad : (rnd == 1 ? 7 - quad : (rnd == 2 ? 8 + quad : 15 - quad));
        const int b = bh >> 3, h = bh & 7;
        const int NT = 4 * qb + 4, td = 4 * qb + (wave >> 1);
        const int qloc = 32 * (wave & 1) + n32;
        for (int c = 0; c < 2; ++c) {
            const bf16* Qp = Qn + ((size_t)(bh * 2 + c) * SEQ + 256 * qb + 32 * wave + n32) * 64 + 8 * hi;
            bf16x8 qf[4];
#pragma unroll
            for (int ds = 0; ds < 4; ++ds) qf[ds] = *(const bf16x8*)(Qp + 16 * ds);
            const bf16* Kp = Kn + (size_t)(bh * 2 + c) * SEQ * 64 + tid * 8;
            const bf16* Vp = Vt + (size_t)bh * 128 * SEQ + (size_t)(tid >> 3) * SEQ + 8 * (tid & 7);
            const int kofs = (tid >> 3) * 144 + (tid & 7) * 16;
            f32x16 o[4];
#pragma unroll
            for (int i = 0; i < 4; ++i)
#pragma unroll
                for (int r = 0; r < 16; ++r) o[i][r] = 0.f;
            float mrun = -INFINITY, lsum = 0.f;
            u32x4 kreg[2], vreg0[2], vreg1[2];
            kreg[0] = gload16_asm(Kp); vreg0[0] = gload16_asm(Vp); vreg1[0] = gload16_asm(Vp + (size_t)64 * SEQ);
            kreg[1] = gload16_asm(Kp + 4096); vreg0[1] = gload16_asm(Vp + 64); vreg1[1] = gload16_asm(Vp + (size_t)64 * SEQ + 64);
            asm volatile("" :: "v"(qf[0]), "v"(qf[1]), "v"(qf[2]), "v"(qf[3]));
            asm volatile("s_waitcnt vmcnt(3)" ::: "memory");
            *(LAS u32x4*)(lds + kofs) = kreg[0]; *(LAS u32x4*)(lds + AT_KB + kofs) = vreg0[0]; *(LAS u32x4*)(lds + AT_KB + 64 * 144 + kofs) = vreg1[0];
            lds_barrier();
            for (int tp = 0; tp < NT; tp += 2) {
#pragma unroll
              for (int hh = 0; hh < 2; ++hh) {
                const int t = tp + hh;
                if (t + 2 < NT) { kreg[hh] = gload16_asm(Kp + (size_t)(t + 2) * 4096); vreg0[hh] = gload16_asm(Vp + 64 * (t + 2)); vreg1[hh] = gload16_asm(Vp + (size_t)64 * SEQ + 64 * (t + 2)); }
                if (t <= td) {
                    const LAS unsigned char* kb = lds + (t & 1) * AT_BUF + n32 * 144 + hi * 16;
                    f32x16 p0, p1;
#pragma unroll
                    for (int r = 0; r < 16; ++r) { p0[r] = 0.f; p1[r] = 0.f; }
                    bf16x8 kf0[4], kf1[4];
#pragma unroll
                    for (int ds = 0; ds < 4; ++ds) { kf0[ds] = *(const LAS bf16x8*)(kb + ds * 32); kf1[ds] = *(const LAS bf16x8*)(kb + 32 * 144 + ds * 32); }
                    const LAS unsigned char* vb = lds + (t & 1) * AT_BUF + AT_KB + n32 * 144 + hi * 16;
                    bf16x8 vf[2][4];
#pragma unroll
                    for (int i = 0; i < 4; ++i) vf[0][i] = *(const LAS bf16x8*)(vb + i * 32 * 144);
                    __builtin_amdgcn_sched_barrier(0);
                    #pragma unroll
                    for (int ds = 0; ds < 4; ++ds) {
                        p0 = __builtin_amdgcn_mfma_f32_32x32x16_bf16(kf0[ds], qf[ds], p0, 0, 0, 0);
                        p1 = __builtin_amdgcn_mfma_f32_32x32x16_bf16(kf1[ds], qf[ds], p1, 0, 0, 0);
                    }
                                        __builtin_amdgcn_sched_barrier(0);
                    if (t == td) {
                        asm volatile("" ::: "memory");
#pragma unroll
                        for (int r = 0; r < 16; ++r) { const int key = (r & 3) + 8 * (r >> 2) + 4 * hi; if (key > qloc) p0[r] = -INFINITY; if (key + 32 > qloc) p1[r] = -INFINITY; }
                    }
                    asm volatile("s_nop 15\n\ts_nop 7" : "+v"(p0), "+v"(p1));
                    float mx, mxb;
                    mx = max3f(p0[0], p0[1], p1[0]); mxb = max3f(p0[2], p0[3], p1[1]); mx = max3f(mx, p1[2], p1[3]);
#pragma unroll
                    for (int r = 4; r < 16; r += 4) { mx = max3f(mx, p0[r], p0[r + 1]); mxb = max3f(mxb, p0[r + 2], p0[r + 3]); mx = max3f(mx, p1[r], p1[r + 1]); mxb = max3f(mxb, p1[r + 2], p1[r + 3]); }
                    mx = max3f(mx, mxb, mxb);
                    { auto rr = __builtin_amdgcn_permlane32_swap(__float_as_uint(mx), __float_as_uint(mx), false, false); mx = max3f(__uint_as_float(rr[0]), __uint_as_float(rr[1]), mrun); }
                    const float mnew = mx;
                    if (__builtin_amdgcn_ballot_w64(mnew > mrun + 8.0f)) {
                        const float alpha = __builtin_amdgcn_exp2f(mrun - mnew);
                        lsum *= alpha;
#pragma unroll
                        for (int i = 0; i < 4; ++i) o[i] = o[i] * alpha;
                        mrun = mnew;
                    }
                    {
                        const f32x2 mm2 = {mrun, mrun};
#pragma unroll
                        for (int r = 0; r < 16; r += 2) { const f32x2 a2 = (f32x2){p0[r], p0[r + 1]} - mm2, b2 = (f32x2){p1[r], p1[r + 1]} - mm2; p0[r] = a2.x; p0[r + 1] = a2.y; p1[r] = b2.x; p1[r + 1] = b2.y; }
                    }
#pragma unroll
                    for (int r = 0; r < 16; ++r) { p0[r] = __builtin_amdgcn_exp2f(p0[r]); p1[r] = __builtin_amdgcn_exp2f(p1[r]); }
                    {
                        const f32x16 ps = p0 + p1;
                        f32x2 s2 = (f32x2){ps[0], ps[1]} + (f32x2){ps[2], ps[3]};
#pragma unroll
                        for (int r = 4; r < 16; r += 2) s2 += (f32x2){ps[r], ps[r + 1]};
                        lsum += s2.x + s2.y;
                    }
                    bf16x8 pf[4];
#pragma unroll
                    for (int s4 = 0; s4 < 4; ++s4) {
                        u32x4 w;
                        if (s4 < 2) { w.x = pk2(p0[8 * s4 + 0], p0[8 * s4 + 1]); w.y = pk2(p0[8 * s4 + 2], p0[8 * s4 + 3]); w.z = pk2(p0[8 * s4 + 4], p0[8 * s4 + 5]); w.w = pk2(p0[8 * s4 + 6], p0[8 * s4 + 7]); }
                        else { const int q = s4 - 2; w.x = pk2(p1[8 * q + 0], p1[8 * q + 1]); w.y = pk2(p1[8 * q + 2], p1[8 * q + 3]); w.z = pk2(p1[8 * q + 4], p1[8 * q + 5]); w.w = pk2(p1[8 * q + 6], p1[8 * q + 7]); }
                        pf[s4] = __builtin_bit_cast(bf16x8, w);
                    }
#pragma unroll
                    for (int s4 = 0; s4 < 4; ++s4) {
                        if (s4 + 1 < 4) {
#pragma unroll
                            for (int i = 0; i < 4; ++i) vf[(s4 + 1) & 1][i] = *(const LAS bf16x8*)(vb + i * 32 * 144 + (s4 + 1) * 32);
                        }
                        __builtin_amdgcn_sched_barrier(0);
                        #pragma unroll
                        for (int i = 0; i < 4; ++i) o[i] = __builtin_amdgcn_mfma_f32_32x32x16_bf16(vf[s4 & 1][i], pf[s4], o[i], 0, 0, 0);
                                                __builtin_amdgcn_sched_barrier(0);
                    }
                }
                if (t + 1 < NT) { if (t + 2 < NT) asm volatile("s_waitcnt vmcnt(3)" ::: "memory"); else asm volatile("s_waitcnt vmcnt(0)" ::: "memory");
                    LAS unsigned char* d = lds + ((t + 1) & 1) * AT_BUF; *(LAS u32x4*)(d + kofs) = kreg[hh ^ 1]; *(LAS u32x4*)(d + AT_KB + kofs) = vreg0[hh ^ 1]; *(LAS u32x4*)(d + AT_KB + 64 * 144 + kofs) = vreg1[hh ^ 1]; }
                lds_barrier();
              }
            }
            const float inv = 1.0f / xhalf_sum(lsum);
            int oz; asm volatile("v_mov_b32 %0, 0" : "=v"(oz));
            float* st = stash + ((size_t)blockIdx.x * 8 + wave) * 4096 + lane + oz;
            if (c == 0) {
#pragma unroll
                for (int i = 0; i < 4; ++i)
#pragma unroll
                    for (int r = 0; r < 16; ++r) st[(i * 16 + r) * 64] = o[i][r] * inv;
            } else {
                float ss = 0.f;
#pragma unroll
                for (int i = 0; i < 4; ++i) {
                    float tv[16];
#pragma unroll
                    for (int r = 0; r < 16; ++r) tv[r] = st[(i * 16 + r) * 64];
                    asm volatile("" ::: "memory");
#pragma unroll
                    for (int r = 0; r < 16; ++r) { const float v = tv[r] - lam * (o[i][r] * inv); o[i][r] = v; ss += v * v; }
                }
                ss = xhalf_sum(ss);
                const float rs = rsqrtf(ss * (1.f / 128.f) + 1e-5f) * (1.0f - LAM_INIT);
                bf16* op = O + (size_t)(b * SEQ + 256 * qb + 32 * wave + n32 + oz) * DM + h * 128 + 4 * hi;
#pragma unroll
                for (int i = 0; i < 4; ++i)
#pragma unroll
                    for (int r4 = 0; r4 < 4; ++r4) {
                        const f32x4 sn = *(const f32x4*)(subn + 32 * i + 8 * r4 + 4 * hi);
                        const f32x4 v = (f32x4){o[i][4 * r4], o[i][4 * r4 + 1], o[i][4 * r4 + 2], o[i][4 * r4 + 3]} * rs * sn;
                        *(u32x2*)(op + 32 * i + 8 * r4) = pk4(v);
                    }
            }
        }
    }
    __builtin_amdgcn_s_setprio(0);
}

#define XB_TMO      128
#define XB_XCNT(j)  (256  + 64 * (j))
#define XB_XSUB(j)  (1280 + 64 * (j))
#define XB_XGEN(j)  (2304 + 64 * (j))
#define XB_TOP      3328
#define XB_TOPGEN   3392
#define XCD_BAR_WORDS 3456
#define XB_SPIN_CAP (1u << 18)

__device__ __forceinline__ unsigned xb_ld(unsigned* p)              { return __hip_atomic_load(p, __ATOMIC_RELAXED, __HIP_MEMORY_SCOPE_AGENT); }
__device__ __forceinline__ unsigned xb_add(unsigned* p, unsigned v) { return __hip_atomic_fetch_add(p, v, __ATOMIC_RELAXED, __HIP_MEMORY_SCOPE_AGENT); }
__device__ __forceinline__ unsigned xb_xcc_id() { return (unsigned)__builtin_amdgcn_s_getreg((3 << 11) | 20) & 0xFu; }
#define XB_SPIN(cond, bar) do { unsigned _sp = 0; while (cond) { __builtin_amdgcn_s_sleep(1); \
    if ((++_sp & 255u) == 0u) { if (xb_ld(&(bar)[XB_TMO])) break; if (_sp > XB_SPIN_CAP) { atomicAdd(&(bar)[XB_TMO], 1u); break; } } } } while (0)

struct XcdBarrier {
    unsigned* bar; unsigned x;
    volatile LAS unsigned* st;
};

__device__ __forceinline__ XcdBarrier xcd_barrier_post(unsigned* bar, volatile LAS unsigned* st) {
    XcdBarrier b; b.bar = bar; b.x = xb_xcc_id(); b.st = st;
    if (threadIdx.x == 0) (void)xb_add(&bar[XB_XCNT(b.x)], 1u);
    return b;
}
__device__ __forceinline__ void xcd_barrier_complete(unsigned* bar, unsigned x, unsigned& nloc, unsigned& nx) {
    const unsigned G = gridDim.x * gridDim.y * gridDim.z;
    unsigned sum, cnt, mine, sp = 0u;
    for (;;) {
        sum = 0u; cnt = 0u; mine = 0u;
#pragma unroll
        for (unsigned j = 0; j < 16; ++j) { const unsigned c = xb_ld(&bar[XB_XCNT(j)]); sum += c; cnt += (c > 0u) ? 1u : 0u; mine = (j == x) ? c : mine; }
        if (sum == G) break;
        __builtin_amdgcn_s_sleep(1);
        if ((++sp & 255u) == 0u) { if (xb_ld(&bar[XB_TMO])) break; if (sp > XB_SPIN_CAP) { atomicAdd(&bar[XB_TMO], 1u); break; } }
    }
    nloc = mine > 0u ? mine : 1u; nx = cnt > 0u ? cnt : 1u;
}

__device__ __forceinline__ void xcd_barrier(const XcdBarrier& b) {
    asm volatile("s_waitcnt vmcnt(0)" ::: "memory");
    __syncthreads();
    if (threadIdx.x == 0) {
        unsigned* bar = b.bar;
        __builtin_amdgcn_s_waitcnt(0);
        unsigned nloc = b.st[0], nx = b.st[1];
        if (nloc == 0u) { xcd_barrier_complete(bar, b.x, nloc, nx); b.st[0] = nloc; b.st[1] = nx; }
        const unsigned old = xb_add(&bar[XB_XSUB(b.x)], 1u);
        const unsigned gen = old / nloc;
        if (old + 1u == (gen + 1u) * nloc) {
            __builtin_amdgcn_fence(__ATOMIC_RELEASE, "agent");
            asm volatile("s_waitcnt vmcnt(0)" ::: "memory");
            const unsigned og = xb_add(&bar[XB_TOP], 1u);
            const unsigned tg = og / nx;
            if (og + 1u == (tg + 1u) * nx) xb_add(&bar[XB_TOPGEN], 1u);
            else XB_SPIN(xb_ld(&bar[XB_TOPGEN]) == tg, bar);
            __builtin_amdgcn_fence(__ATOMIC_ACQUIRE, "agent");
            xb_add(&bar[XB_XGEN(b.x)], 1u);
            asm volatile("s_waitcnt vmcnt(0)" ::: "memory");
        } else {
            XB_SPIN(xb_ld(&bar[XB_XGEN(b.x)]) == gen, bar);
            __builtin_amdgcn_fence(__ATOMIC_ACQUIRE, "agent");
            asm volatile("s_waitcnt vmcnt(0)" ::: "memory");
        }
    }
    __syncthreads();
}

#ifndef KMASK
#define KMASK 0xffff
#endif
#define KON(k) ((KMASK >> (k)) & 1)
constexpr int N_PHASES = 20;
__global__ void __launch_bounds__(NTHR, 2) mega_fwd(Args a) {
    extern __shared__ __attribute__((aligned(16))) unsigned char lds_raw[];
    LAS unsigned char* lds = (LAS unsigned char*)lds_raw;
    cg::grid_group grid = cg::this_grid();
    volatile LAS unsigned* bst = (volatile LAS unsigned*)(lds + 131072);
    if (threadIdx.x < 2) bst[threadIdx.x] = 0u;
    __syncthreads();
    const XcdBarrier xbar = xcd_barrier_post((unsigned*)(a.ws + WS_BAR), bst);
#ifndef KREP
#define KREP 0
#endif
    int rep = 0; (void)rep;
    for (int ph = a.ph_lo; ph < a.ph_hi; ++ph) {
        int oz; asm volatile("s_mov_b32 %0, 0" : "=s"(oz));
        const int tid = threadIdx.x + oz, lane = tid & 63, wave = __builtin_amdgcn_readfirstlane(tid >> 6);
        const int gw = blockIdx.x * NWAVES + wave, NGW = gridDim.x * NWAVES;
        unsigned char* ws = a.ws + oz;
        bf16* XN = (bf16*)(ws + WS_XN);
        bf16* BIG = (bf16*)(ws + WS_BIG);
        float* X = a.out + oz;
        int kind = 0, idx = 0;
        switch (ph) {
            case 0: kind = 0; break;
            case 1: kind = 1; idx = 0; break;
            case 2: kind = 2; idx = 0; break;
            case 3: kind = 4; idx = 0; break;
            case 4: kind = 5; break;
            case 5: kind = 6; break;
            case 6: kind = 7; break;
            case 7: kind = 8; break;
            case 8: kind = 9; break;
            case 9: kind = 10; idx = 0; break;
            case 10: kind = 1; idx = 1; break;
            case 11: kind = 2; idx = 1; break;
            case 12: kind = 1; idx = 2; break;
            case 13: kind = 2; idx = 2; break;
            case 14: kind = 4; idx = 1; break;
            case 15: kind = 11; break;
            case 16: kind = 12; break;
            case 17: kind = 10; idx = 1; break;
            case 18: kind = 1; idx = 3; break;
            default: kind = 2; idx = 3; break;
        }
        float* RSQ = (float*)(ws + WS_RSQ);
        if (kind == 0) { if (KON(0))
            prologue_phase(a, lds, tid, lane, wave);
        } else if (kind == 1) { if (KON(1)) {
            EpiSwiGLU E{BIG, ph == 1 ? (const float*)nullptr : (const float*)RSQ};
            run_gemm(lds, XN, (const bf16*)(ws + WS_WGU + idx * WGU_STRIDE), 2 * DFF, DM, E); }
        } else if (kind == 2 || kind == 10) { if (KON(2)) {
            const bool dn = kind == 2;
            const float* gn = ph == 2 ? a.in[5] : (ph == 9 ? a.in[1] + DM : (ph == 11 ? a.in[1] + 2 * DM : (ph == 13 ? a.in[5] + DM : (ph == 17 ? a.in[1] + 3 * DM : (const float*)nullptr))));
            EpiResid E{ph == 2 ? a.in[0] : (const float*)X, X, gn, XN, RSQ, dn ? 0.5f : 1.0f, 0.f};
            const bf16* A = dn ? (const bf16*)BIG : (idx == 0 ? (const bf16*)(ws + WS_R1) : (const bf16*)BIG);
            const bf16* Bt = dn ? (const bf16*)(ws + WS_WD + idx * WD_STRIDE) : (const bf16*)(ws + (idx == 0 ? WS_WEOUT : WS_WCOUT));
            run_gemm(lds, A, Bt, DM, dn ? DFF : DM, E); }
        } else if (kind == 4) { if (KON(4)) {
            EpiStore E{BIG, idx == 0 ? ZW : Z3W, (const float*)RSQ};
            run_gemm(lds, XN, (const bf16*)(ws + (idx == 0 ? WS_WAIN : WS_WCIN)), idx == 0 ? ZW : Z3W, DM, E); }
        } else if (kind == 5) { if (KON(5))
            e1_phase(BIG, a.in[7], (bf16*)(ws + WS_LRIN), tid);
        } else if (kind == 6) { if (KON(6)) {
            EpiLowRank E{(float*)(ws + WS_R1), (bf16*)(ws + WS_R2), (bf16*)(ws + WS_R4), a.in[8], a.in[10]};
            run_gemm(lds, (const bf16*)(ws + WS_LRIN), (const bf16*)(ws + WS_WBD), 1536, 256, E); }
        } else if (kind == 7) { if (KON(7))
            e2_phase(a, BIG, (bf16*)(ws + WS_R2), (float*)(ws + WS_R1), (bf16*)(ws + WS_R3), (float*)(ws + WS_BON), gw, NGW, lane);
        } else if (kind == 8) { if (KON(8))
            scan_phase(a, lds, BIG, (const float*)(ws + WS_R1), (const bf16*)(ws + WS_R2), (const bf16*)(ws + WS_R3), (float*)(ws + WS_XN), tid, lane, wave);
        } else if (kind == 9) { if (KON(9))
            e3_phase(a, lds, BIG, (const float*)(ws + WS_XN), (const float*)(ws + WS_BON), (const bf16*)(ws + WS_R4), (bf16*)(ws + WS_R1), tid, lane, wave);
        } else if (kind == 11) { if (KON(11))
            qkrope_phase(a, lds, BIG, (bf16*)(ws + WS_XN), (bf16*)(ws + WS_R1), (bf16*)(ws + WS_R2), tid, lane, wave);
        } else { if (KON(12))
            attn_phase(a, lds, (const bf16*)(ws + WS_XN), (const bf16*)(ws + WS_R1), (const bf16*)(ws + WS_R2), BIG, (float*)(ws + WS_BIG + 64 * MiB), tid, lane, wave);
        }
#if KREP
        if (!rep && ((KREP >> kind) & 1)) { rep = 1; --ph; } else rep = 0;
#endif
        if (ph + 1 < a.ph_hi) {
            if (ph == a.ph_lo) grid.sync(); else xcd_barrier(xbar);
        }
    }
}

#ifndef MK_PER_PHASE
#define MK_PER_PHASE 0
#endif
extern "C" void kernel_launch(void* const* d_in, const int* in_sizes, int n_in, void* d_out, int out_size, void* d_ws, size_t ws_size, hipStream_t stream) {
    static int grid = 0;
    if (grid == 0) {
        if (n_in != 33 || out_size != T * DM || ws_size < WS_END) { fprintf(stderr, "kernel_launch: unexpected shapes (n_in %d out %d ws %zu)\n", n_in, out_size, ws_size); grid = -1; return; }
        int dev = 0, cus = 0, per_cu = 0;
        hipGetDevice(&dev);
        hipDeviceGetAttribute(&cus, hipDeviceAttributeMultiprocessorCount, dev);
        if (hipFuncSetAttribute((const void*)mega_fwd, hipFuncAttributeMaxDynamicSharedMemorySize, LDS_BYTES) != hipSuccess) { fprintf(stderr, "kernel_launch: hipFuncSetAttribute failed\n"); grid = -1; return; }
        if (hipOccupancyMaxActiveBlocksPerMultiprocessor(&per_cu, (const void*)mega_fwd, NTHR, LDS_BYTES) != hipSuccess || per_cu < 1) { fprintf(stderr, "kernel_launch: occupancy query says %d\n", per_cu); per_cu = 1; }
        (void)hipGetLastError();
        grid = cus * per_cu;
    }
    if (grid < 0) return;
    if (hipMemsetAsync((char*)d_ws + WS_BAR, 0, 16384, stream) != hipSuccess) { fprintf(stderr, "kernel_launch: memset of the barrier words failed\n"); return; }
    Args a{};
    for (int i = 0; i < 33; ++i) a.in[i] = (const float*)d_in[i];
    a.out = (float*)d_out; a.ws = (unsigned char*)d_ws;
#if MK_PER_PHASE
    for (int ph = 0; ph < N_PHASES; ++ph) { a.ph_lo = ph; a.ph_hi = ph + 1; hipLaunchKernelGGL(mega_fwd, dim3(grid), dim3(NTHR), LDS_BYTES, stream, a); }
#else
    a.ph_lo = 0; a.ph_hi = N_PHASES;
    void* kargs[] = {&a};
    hipError_t e = hipLaunchCooperativeKernel((const void*)mega_fwd, dim3(grid), dim3(NTHR), kargs, LDS_BYTES, stream);
    if (e != hipSuccess) fprintf(stderr, "cooperative launch failed: %s (grid %d)\n", hipGetErrorString(e), grid);
#endif
}
```

```cpp
#include <hip/hip_runtime.h>
#include <hip/hip_cooperative_groups.h>
#include <cstdio>
#include <cstdint>
#include <cmath>
namespace cg = cooperative_groups;
namespace pg8 {
#define PG8_LAS __attribute__((address_space(3)))
typedef unsigned short bf16_t;
typedef short bf16x8 __attribute__((ext_vector_type(8)));
typedef float f32x4 __attribute__((ext_vector_type(4)));
typedef unsigned u32x4 __attribute__((ext_vector_type(4)));
constexpr int BM = 256, BK = 64, HALF = 128, HTB = HALF * BK * 2  , STAGE_BYTES = 8 * HTB, NXCD = 8, WGM = 8;

__host__ __device__ __forceinline__ int lds_byte(int r, int c) { const int st = (r >> 4) * 2 + (c >> 5), rr = r & 15, cc = c & 31, ob = rr * 64 + cc * 2; return st * 1024 + (ob ^ (((ob >> 9) & 1) << 5)); }
__host__ __device__ __forceinline__ void stage_rc(int b, int& R, int& C) { const int st = b / 1024, sb = b % 1024, swz = sb ^ (((sb >> 9) & 1) << 5); R = (st >> 1) * 16 + swz / 64; C = (st & 1) * 32 + (swz % 64) / 2; }
__host__ __device__ __forceinline__ int perm32(int rho) { const int n = rho >> 4, i = rho & 15; return 8 * (i >> 2) + 4 * n + (i & 3); }

struct Unit { int pm, pn; };
struct Gemm { const bf16_t* A; const bf16_t* Bt; int M, N, K; };

struct StaticOrder {
    int nM, nN, nwg, G, c;
    __host__ __device__ void init(int M, int N, int G_, int c_) { nM = M / BM; nN = N / BM; nwg = nM * nN; G = G_; c = c_; }
    __host__ __device__ bool next(int i, Unit& u) const {
        const long L = (long)i * G + c; if (L >= nwg) return false;
        int wgid = (int)L; { const int q = nwg / NXCD, r = nwg % NXCD, xcd = wgid % NXCD, off = wgid / NXCD; wgid = (xcd < r ? xcd * (q + 1) : r * (q + 1) + (xcd - r) * q) + off; }
        const int nig = WGM * nN, gid = wgid / nig, fm = gid * WGM, gsz = (nM - fm) < WGM ? (nM - fm) : WGM;
        u.pm = fm + ((wgid % nig) % gsz); u.pn = (wgid % nig) / gsz; return true;
    }
    __device__ __forceinline__ void a_ready(const Unit&) const {}
    __device__ __forceinline__ void done(const Unit&) const {}
};

__device__ __forceinline__ unsigned cvt_pk_bf16(float lo, float hi) { unsigned r; asm volatile("v_cvt_pk_bf16_f32 %0, %1, %2" : "=v"(r) : "v"(lo), "v"(hi)); return r; }
typedef float f32x2 __attribute__((ext_vector_type(2)));
__device__ __forceinline__ f32x2 gelu_pk(f32x2 v) {
    const f32x2 av = __builtin_elementwise_abs(v), d = av * 0.2316418882f + 1.0f;
    f32x2 t; t.x = __builtin_amdgcn_rcpf(d.x); t.y = __builtin_amdgcn_rcpf(d.y);
    f32x2 q = t * 0.5307027145f + (-0.7265760135f); q = q * t + 0.7107068705f; q = q * t + (-0.142248368f); q = q * t + 0.127414796f; q = q * t;
    const f32x2 s = (v * v) * (-0.72134752044f);
    f32x2 e; e.x = __builtin_amdgcn_exp2f(s.x); e.y = __builtin_amdgcn_exp2f(s.y);
    const f32x2 m = v * (q * e), r = v - m;
    f32x2 o; o.x = v.x < 0.f ? m.x : r.x; o.y = v.y < 0.f ? m.y : r.y; return o;
}

template <int ACT  > struct EpiBf16 {
    static constexpr bool PERM = true, AFTER_DRAIN = false; static_assert(ACT == 0 || ACT == 1, "EpiBf16: ACT is 0 (none) or 1 (gelu_pk)");
    bf16_t* O; int ldc; const float* bias; int split_cols; size_t split_stride; float scale0;
    __device__ __forceinline__ void operator()(const f32x4 (&acc)[2][2][4][2], const Unit& u, int wr, int wc, int fr, int fq) const {
        const int row0 = u.pm * BM + wr * 64 + fr; int colt = u.pn * BM; bf16_t* base = O;
        float sc = 1.f; if (split_cols) { const int t = colt / split_cols; base += (size_t)t * split_stride; colt -= t * split_cols; if (t == 0) sc = scale0; }
        const int col0 = colt + wc * 32 + 8 * fq, bcol0 = u.pn * BM + wc * 32 + 8 * fq;
        f32x4 bv[2][2];
#pragma unroll
        for (int bj = 0; bj < 2; ++bj)
#pragma unroll
            for (int n = 0; n < 2; ++n) bv[bj][n] = bias ? *(const f32x4*)(bias + bcol0 + bj * HALF + 4 * n) : (f32x4){0.f, 0.f, 0.f, 0.f};
#pragma unroll
        for (int ai = 0; ai < 2; ++ai)
#pragma unroll
            for (int m = 0; m < 4; ++m) { bf16_t* rowp = base + (size_t)(row0 + ai * HALF + m * 16) * ldc + col0;
#pragma unroll
                for (int bj = 0; bj < 2; ++bj) { f32x4 v0 = acc[ai][bj][m][0] + bv[bj][0], v1 = acc[ai][bj][m][1] + bv[bj][1];
                    if (ACT == 1) { f32x2 a = gelu_pk((f32x2){v0[0], v0[1]}), b = gelu_pk((f32x2){v0[2], v0[3]}), c = gelu_pk((f32x2){v1[0], v1[1]}), d = gelu_pk((f32x2){v1[2], v1[3]});
                        v0 = (f32x4){a.x, a.y, b.x, b.y}; v1 = (f32x4){c.x, c.y, d.x, d.y}; }
                    v0 = v0 * sc; v1 = v1 * sc; u32x4 w; w.x = cvt_pk_bf16(v0[0], v0[1]); w.y = cvt_pk_bf16(v0[2], v0[3]); w.z = cvt_pk_bf16(v1[0], v1[1]); w.w = cvt_pk_bf16(v1[2], v1[3]);
                    *(u32x4*)(rowp + bj * HALF) = w; } }
    }
};
template <class Epi, class Sched, bool ALIGN_EPI = false, bool SP2 = false>
__device__ __forceinline__ void gemm_phase(PG8_LAS unsigned char* lds, const Gemm g, const Sched& S, const Epi& E) {
    int oz_; asm volatile("s_mov_b32 %0, 0" : "=s"(oz_));
    const int tid = threadIdx.x + oz_, wid = __builtin_amdgcn_readfirstlane(tid >> 6), lane = tid & 63, wr = wid >> 2, wc = wid & 3, fr = lane & 15, fq = lane >> 4;
    const int K = g.K, nt = K / BK;
    unsigned voffA[2], voffB[2];
#pragma unroll
    for (int i = 0; i < 2; ++i) { int R, C; stage_rc(tid * 16 + i * 8192, R, C); const int Rb = Epi::PERM ? ((R & ~31) + perm32(R & 31)) : R;
        voffA[i] = (unsigned)(R * K + C) * 2u; voffB[i] = (unsigned)(Rb * K + C) * 2u; }
    const size_t kstep = (size_t)(BK * 2);
    const size_t hstep = (size_t)HALF * K * 2;
    const size_t tstep = 2 * hstep;
    const unsigned ldsw = (unsigned)wid * 1024u;
    const int aoff = lds_byte(wr * 64 + fr, fq * 8), boff = lds_byte(wc * 32 + fr, fq * 8);
#define PG8_SA(b, h) (((b) * 2 + (h)) * HTB)
#define PG8_SB(b, h) ((4 + (b) * 2 + (h)) * HTB)
#define PG8_STAGE(bufoff, gbase, voff) do { _Pragma("unroll") for (int _i = 0; _i < 2; ++_i) \
        __builtin_amdgcn_global_load_lds((const unsigned*)((const char*)(gbase) + (voff)[_i]), (PG8_LAS unsigned*)(lds + (bufoff) + ldsw + _i * 8192), 16, 0, 0); } while (0)
#define PG8_LDA(dst, b, h) do { _Pragma("unroll") for (int m = 0; m < 4; ++m) _Pragma("unroll") for (int k = 0; k < 2; ++k) dst[m][k] = *(const PG8_LAS bf16x8*)(lds + PG8_SA(b, h) + aoff + m * 2048 + k * 1024); } while (0)
#define PG8_LDB(dst, b, h) do { _Pragma("unroll") for (int n = 0; n < 2; ++n) _Pragma("unroll") for (int k = 0; k < 2; ++k) dst[n][k] = *(const PG8_LAS bf16x8*)(lds + PG8_SB(b, h) + boff + n * 2048 + k * 1024); } while (0)
#define PG8_MMA(ai, bj, At, Bt) do { __builtin_amdgcn_s_setprio(1); _Pragma("unroll") for (int m = 0; m < 4; ++m) _Pragma("unroll") for (int n = 0; n < 2; ++n) _Pragma("unroll") for (int k = 0; k < 2; ++k) \
        acc[ai][bj][m][n] = __builtin_amdgcn_mfma_f32_16x16x32_bf16(Bt[n][k], At[m][k], acc[ai][bj][m][n], 0, 0, 0); __builtin_amdgcn_s_setprio(0); } while (0)
#define PG8_WAIT_V(n) asm volatile("s_waitcnt vmcnt(" #n ")" ::: "memory")
#define PG8_WAIT_L(n) asm volatile("s_waitcnt lgkmcnt(" #n ")" ::: "memory")
#define PG8_BAR __builtin_amdgcn_s_barrier()
#define PG8_SCHED __builtin_amdgcn_sched_barrier(0)
    Unit cur, nxt; int ui = 0;
    if (!S.next(0, cur)) return;
    f32x4 acc[2][2][4][2];
#pragma unroll
    for (int a = 0; a < 2; ++a)
#pragma unroll
        for (int b = 0; b < 2; ++b)
#pragma unroll
            for (int m = 0; m < 4; ++m)
#pragma unroll
                for (int n = 0; n < 2; ++n) acc[a][b][m][n] = (f32x4){0.f, 0.f, 0.f, 0.f};
    bf16x8 At[4][2], B0[2][2], B1[2][2];
    const char* cA = (const char*)g.A + (size_t)cur.pm * tstep; const char* cB = (const char*)g.Bt + (size_t)cur.pn * tstep;
    S.a_ready(cur);
    if constexpr (SP2) {
        PG8_STAGE(PG8_SB(0, 0), cB, voffB); PG8_STAGE(PG8_SB(0, 1), cB + hstep, voffB); PG8_STAGE(PG8_SA(0, 0), cA, voffA); PG8_STAGE(PG8_SA(0, 1), cA + hstep, voffA);
        if (wr == 1) PG8_BAR;
        PG8_WAIT_V(2); PG8_BAR;
        PG8_STAGE(PG8_SB(1, 0), cB + kstep, voffB); PG8_STAGE(PG8_SA(1, 0), cA + kstep, voffA); PG8_STAGE(PG8_SB(1, 1), cB + hstep + kstep, voffB);
        PG8_WAIT_V(6); PG8_BAR;
    } else {
        PG8_STAGE(PG8_SB(0, 0), cB, voffB); PG8_STAGE(PG8_SA(0, 0), cA, voffA); PG8_STAGE(PG8_SB(0, 1), cB + hstep, voffB); PG8_STAGE(PG8_SA(0, 1), cA + hstep, voffA);
        if (wr == 1) PG8_BAR;
        PG8_WAIT_V(4); PG8_BAR;
        PG8_STAGE(PG8_SB(1, 0), cB + kstep, voffB); PG8_STAGE(PG8_SA(1, 0), cA + kstep, voffA); PG8_STAGE(PG8_SB(1, 1), cB + hstep + kstep, voffB);
        PG8_WAIT_V(6); PG8_BAR;
    }
    for (;;) {
        const bool has_next = S.next(ui + 1, nxt);
        const char* nA = has_next ? (const char*)g.A + (size_t)nxt.pm * tstep : cA; const char* nB = has_next ? (const char*)g.Bt + (size_t)nxt.pn * tstep : cB;
        for (int t = 0; t < nt; t += 2) {
            const bool last = (t == nt - 2);
            const char* a1 = cA + (size_t)(t + 1) * kstep;
            const char* a2 = last ? nA : cA + (size_t)(t + 2) * kstep; const char* b2 = last ? nB : cB + (size_t)(t + 2) * kstep;
            const char* a3 = a2 + kstep; const char* b3 = b2 + kstep;
            if (last && has_next) S.a_ready(nxt);
            if constexpr (SP2) {
            PG8_LDB(B0, 0, 0); PG8_LDB(B1, 0, 1); PG8_SCHED; PG8_LDA(At, 0, 0); PG8_STAGE(PG8_SA(1, 1), a1 + hstep, voffA);
            PG8_WAIT_V(8); PG8_WAIT_L(0); PG8_BAR; PG8_MMA(0, 0, At, B0); PG8_MMA(0, 1, At, B1); PG8_BAR; PG8_SCHED;
            PG8_LDA(At, 0, 1); PG8_STAGE(PG8_SB(0, 0), b2, voffB); PG8_STAGE(PG8_SB(0, 1), b2 + hstep, voffB); PG8_STAGE(PG8_SA(0, 0), a2, voffA);
            PG8_WAIT_V(8); PG8_WAIT_L(0); PG8_BAR; PG8_MMA(1, 0, At, B0); PG8_MMA(1, 1, At, B1); PG8_BAR; PG8_SCHED;
            PG8_LDB(B0, 1, 0); PG8_LDB(B1, 1, 1); PG8_SCHED; PG8_LDA(At, 1, 0); PG8_STAGE(PG8_SA(0, 1), a2 + hstep, voffA);
            PG8_WAIT_V(8); PG8_WAIT_L(0); PG8_BAR; PG8_MMA(0, 0, At, B0); PG8_MMA(0, 1, At, B1); PG8_BAR; PG8_SCHED;
            PG8_LDA(At, 1, 1); PG8_STAGE(PG8_SB(1, 0), b3, voffB); PG8_STAGE(PG8_SB(1, 1), b3 + hstep, voffB); PG8_STAGE(PG8_SA(1, 0), a3, voffA);
            PG8_WAIT_V(8); PG8_WAIT_L(0); PG8_BAR; PG8_MMA(1, 0, At, B0); PG8_MMA(1, 1, At, B1); PG8_BAR; PG8_SCHED;
            } else {
            PG8_LDB(B0, 0, 0); PG8_SCHED; PG8_LDA(At, 0, 0); PG8_STAGE(PG8_SA(1, 1), a1 + hstep, voffA);
            PG8_WAIT_L(8); PG8_BAR; PG8_WAIT_L(0); PG8_MMA(0, 0, At, B0); PG8_BAR; PG8_SCHED;
            PG8_LDB(B1, 0, 1); PG8_STAGE(PG8_SB(0, 0), b2, voffB);
            PG8_BAR; PG8_WAIT_L(0); PG8_MMA(0, 1, At, B1); PG8_BAR;
            PG8_LDA(At, 0, 1); PG8_STAGE(PG8_SA(0, 0), a2, voffA);
            PG8_BAR; PG8_WAIT_L(0); PG8_MMA(1, 0, At, B0); PG8_BAR; PG8_SCHED;
            PG8_STAGE(PG8_SB(0, 1), b2 + hstep, voffB);
            PG8_WAIT_V(6); PG8_BAR; PG8_MMA(1, 1, At, B1); PG8_BAR;
            PG8_LDB(B0, 1, 0); PG8_SCHED; PG8_LDA(At, 1, 0); PG8_STAGE(PG8_SA(0, 1), a2 + hstep, voffA);
            PG8_WAIT_L(8); PG8_BAR; PG8_WAIT_L(0); PG8_MMA(0, 0, At, B0); PG8_BAR; PG8_SCHED;
            PG8_LDB(B1, 1, 1); PG8_STAGE(PG8_SB(1, 0), b3, voffB);
            PG8_BAR; PG8_WAIT_L(0); PG8_MMA(0, 1, At, B1); PG8_BAR;
            PG8_LDA(At, 1, 1); PG8_STAGE(PG8_SA(1, 0), a3, voffA);
            PG8_BAR; PG8_WAIT_L(0); PG8_MMA(1, 0, At, B0); PG8_BAR; PG8_SCHED;
            PG8_STAGE(PG8_SB(1, 1), b3 + hstep, voffB);
            PG8_WAIT_V(6); PG8_BAR; PG8_MMA(1, 1, At, B1); PG8_BAR;
            }
        }
        if constexpr (ALIGN_EPI) { if (wr == 0) PG8_BAR; }
        if constexpr (!Epi::AFTER_DRAIN) { E(acc, cur, wr, wc, fr, fq); S.done(cur); }
        if (!has_next) break;
#pragma unroll
        for (int a = 0; a < 2; ++a)
#pragma unroll
            for (int b = 0; b < 2; ++b)
#pragma unroll
                for (int m = 0; m < 4; ++m)
#pragma unroll
                    for (int n = 0; n < 2; ++n) acc[a][b][m][n] = (f32x4){0.f, 0.f, 0.f, 0.f};
        cur = nxt; cA = nA; cB = nB; ++ui;
        if constexpr (ALIGN_EPI) { if (wr == 1) PG8_BAR; }
    }
    PG8_WAIT_V(0);
    if constexpr (!ALIGN_EPI) { if (wr == 0) PG8_BAR; }
    PG8_BAR;
    if constexpr (Epi::AFTER_DRAIN) { E.fused(acc, cur, wr, wc, fr, fq, lds, wid, lane); S.done(cur); }
#undef PG8_SA
#undef PG8_SB
#undef PG8_STAGE
#undef PG8_LDA
#undef PG8_LDB
#undef PG8_MMA
#undef PG8_WAIT_V
#undef PG8_WAIT_L
#undef PG8_BAR
#undef PG8_SCHED
}
}

#define LAS __attribute__((address_space(3)))
typedef unsigned short bf16;
typedef float f32x4 __attribute__((ext_vector_type(4)));
typedef float f32x2 __attribute__((ext_vector_type(2)));
typedef float f32x16 __attribute__((ext_vector_type(16)));
typedef short bf16x8 __attribute__((ext_vector_type(8)));
typedef unsigned u32x4 __attribute__((ext_vector_type(4)));
typedef unsigned u32x2 __attribute__((ext_vector_type(2)));
typedef __bf16 bf16x2_t __attribute__((ext_vector_type(2)));

constexpr int NWAVES = 8, NTHR = 512;
constexpr int BATCH = 8, SEQ = 4096, DM = 1024, T = BATCH * SEQ, DFF = 2816;
constexpr int ZW = 2816;
constexpr int Z3W = 3072;
constexpr int LDS_BYTES = 147456;
constexpr float LAM_INIT = 0.35550906759096934f;
constexpr float QSCALE = 0.125f * 1.4426950408889634f;

constexpr size_t MiB = 1u << 20;
constexpr size_t WS_WGU = 0;
constexpr size_t WGU_STRIDE = (size_t)5632 * 1024 * 2;
constexpr size_t WS_WD = 44 * MiB;
constexpr size_t WD_STRIDE = (size_t)1024 * 2816 * 2;
constexpr size_t WS_WAIN = 66 * MiB;
constexpr size_t WS_WEOUT = 72 * MiB;
constexpr size_t WS_WCIN = 74 * MiB;
constexpr size_t WS_WCOUT = 80 * MiB;
constexpr size_t WS_WBD = 82 * MiB;
constexpr size_t WS_ROPE = 83 * MiB;
constexpr size_t WS_BON = 84 * MiB;
constexpr size_t WS_LAM = 85 * MiB;
constexpr size_t WS_BAR = 85 * MiB + 65536;
constexpr size_t WS_RSQ = 86 * MiB;
constexpr size_t WS_XN = 88 * MiB;
constexpr size_t WS_BIG = 152 * MiB;
constexpr size_t WS_LRIN = 328 * MiB;
constexpr size_t WS_R1 = 344 * MiB;
constexpr size_t WS_R2 = 408 * MiB;
constexpr size_t WS_R3 = 440 * MiB;
constexpr size_t WS_R4 = 472 * MiB;
constexpr size_t WS_END = 504 * MiB;

__device__ const float ROPE_INV[32] = {
    1.000000000e+00f, 7.498942018e-01f, 5.623413324e-01f, 4.216965139e-01f, 3.162277639e-01f, 2.371373922e-01f, 1.778279394e-01f, 1.333521456e-01f,
    1.000000015e-01f, 7.498941571e-02f, 5.623412877e-02f, 4.216964915e-02f, 3.162277862e-02f, 2.371373586e-02f, 1.778279431e-02f, 1.333521493e-02f,
    9.999999776e-03f, 7.498942316e-03f, 5.623413250e-03f, 4.216964822e-03f, 3.162277862e-03f, 2.371373819e-03f, 1.778279431e-03f, 1.333521446e-03f,
    1.000000047e-03f, 7.498941850e-04f, 5.623413017e-04f, 4.216965463e-04f, 3.162277862e-04f, 2.371373848e-04f, 1.778279402e-04f, 1.333521504e-04f};

__device__ __forceinline__ unsigned pk2(float lo, float hi) { f32x2 v = {lo, hi}; bf16x2_t b = __builtin_convertvector(v, bf16x2_t); return __builtin_bit_cast(unsigned, b); }
__device__ __forceinline__ float bflo(unsigned u) { return __uint_as_float(u << 16); }
__device__ __forceinline__ float bfhi(unsigned u) { return __uint_as_float(u & 0xffff0000u); }
__device__ __forceinline__ f32x4 bf4(u32x2 u) { return (f32x4){bflo(u.x), bfhi(u.x), bflo(u.y), bfhi(u.y)}; }
__device__ __forceinline__ u32x2 pk4(f32x4 v) { u32x2 r; r.x = pk2(v.x, v.y); r.y = pk2(v.z, v.w); return r; }
__device__ __forceinline__ float fexp(float x) { return __builtin_amdgcn_exp2f(x * 1.4426950408889634f); }
__device__ __forceinline__ float fsigmoid(float x) { return __builtin_amdgcn_rcpf(1.0f + fexp(-x)); }
__device__ __forceinline__ float ftanh(float x) { return 1.0f - 2.0f * __builtin_amdgcn_rcpf(fexp(2.0f * x) + 1.0f); }
template <int CTRL> __device__ __forceinline__ float dppf(float v) { return __int_as_float(__builtin_amdgcn_update_dpp(0, __float_as_int(v), CTRL, 0xf, 0xf, true)); }
__device__ __forceinline__ float red8(float v) { v += dppf<0xB1>(v); v += dppf<0x4E>(v); v += dppf<0x141>(v); return v; }
__device__ __forceinline__ float red16(float v) { v = red8(v); v += dppf<0x140>(v); return v; }
__device__ __forceinline__ float wave_sum(float v) {
    v = red16(v);
    const int i = __float_as_int(v);
    const float a0 = __int_as_float(__builtin_amdgcn_readlane(i, 0)), a1 = __int_as_float(__builtin_amdgcn_readlane(i, 16)), a2 = __int_as_float(__builtin_amdgcn_readlane(i, 32)), a3 = __int_as_float(__builtin_amdgcn_readlane(i, 48));
    return (a0 + a1) + (a2 + a3);
}
__device__ __forceinline__ float xhalf_sum(float v);
__device__ __forceinline__ float fq_sum(float v) {
    v += __int_as_float(__builtin_amdgcn_ds_swizzle(__float_as_int(v), 0x401F));
    auto rr = __builtin_amdgcn_permlane32_swap(__float_as_uint(v), __float_as_uint(v), false, false); return __uint_as_float(rr[0]) + __uint_as_float(rr[1]);
}
__device__ __forceinline__ float max3f(float a, float b, float c) { float r; asm("v_max3_f32 %0, %1, %2, %3" : "=v"(r) : "v"(a), "v"(b), "v"(c)); return r; }
__device__ __forceinline__ float xhalf_max(float v) { auto rr = __builtin_amdgcn_permlane32_swap(__float_as_uint(v), __float_as_uint(v), false, false); return fmaxf(__uint_as_float(rr[0]), __uint_as_float(rr[1])); }
__device__ __forceinline__ float xhalf_sum(float v) { auto rr = __builtin_amdgcn_permlane32_swap(__float_as_uint(v), __float_as_uint(v), false, false); return __uint_as_float(rr[0]) + __uint_as_float(rr[1]); }

__device__ __forceinline__ void lds_barrier() { asm volatile("s_waitcnt lgkmcnt(0)" ::: "memory"); __builtin_amdgcn_s_barrier(); asm volatile("" ::: "memory"); }
__device__ __forceinline__ u32x4 gload16_asm(const void* p) { u32x4 r; asm volatile("global_load_dwordx4 %0, %1, off" : "=v"(r) : "v"(p) : "memory"); return r; }
struct Args { const float* in[33]; float* out; unsigned char* ws; int ph_lo, ph_hi; };

__device__ __forceinline__ void row_rstd8(const float* rsq, int row0, int fq, float (&rs)[8]) {
    if (!rsq) {
#pragma unroll
        for (int i = 0; i < 8; ++i) rs[i] = 1.f;
        return;
    }
    f32x4 p[8];
#pragma unroll
    for (int i = 0; i < 8; ++i) p[i] = *(const f32x4*)(rsq + (size_t)(row0 + (i >> 2) * 128 + (i & 3) * 16) * 16 + 4 * fq);
    asm volatile("" ::: "memory");
#pragma unroll
    for (int i = 0; i < 8; ++i) rs[i] = rsqrtf(fq_sum((p[i].x + p[i].y) + (p[i].z + p[i].w)) * (1.f / DM) + 1e-6f);
}
struct EpiSwiGLU {
    static constexpr bool PERM = true, AFTER_DRAIN = false;
    bf16* O;
    const float* rsq;
    __device__ __forceinline__ void operator()(const pg8::f32x4 (&acc)[2][2][4][2], const pg8::Unit& u, int wr, int wc, int fr, int fq) const {
        int oz; asm volatile("v_mov_b32 %0, 0" : "=v"(oz));
        const int row0 = u.pm * 256 + wr * 64 + fr + oz, col0 = u.pn * 128 + wc * 32 + 8 * fq;
        float rs8[8]; row_rstd8(rsq, row0, fq, rs8);
#pragma unroll
        for (int ai = 0; ai < 2; ++ai)
#pragma unroll
            for (int m = 0; m < 4; ++m) {
                bf16* p = O + (size_t)(row0 + ai * 128 + m * 16) * DFF + col0;
                const float r = rs8[ai * 4 + m];
                const f32x2 rr2 = {r * r, r * r}, nl2 = {-1.4426950408889634f * r, -1.4426950408889634f * r};
                unsigned w[4];
#pragma unroll
                for (int n = 0; n < 2; ++n)
#pragma unroll
                    for (int e = 0; e < 4; e += 2) {
                        const f32x2 ag = {acc[ai][0][m][n][e], acc[ai][0][m][n][e + 1]}, au = {acc[ai][1][m][n][e], acc[ai][1][m][n][e + 1]};
                        const f32x2 x = ag * nl2;
                        f32x2 d = {__builtin_amdgcn_exp2f(x.x), __builtin_amdgcn_exp2f(x.y)};
                        d = d + 1.0f;
                        const f32x2 rc = {__builtin_amdgcn_rcpf(d.x), __builtin_amdgcn_rcpf(d.y)};
                        const f32x2 hh = (ag * au) * (rc * rr2);
                        w[2 * n + (e >> 1)] = pk2(hh.x, hh.y);
                    }
                __builtin_nontemporal_store((u32x4){w[0], w[1], w[2], w[3]}, (u32x4*)p);
            }
    }
};
struct EpiResid {
    static constexpr bool PERM = false, AFTER_DRAIN = false;
    const float* base; float* out; const float* gn; bf16* XN; float* rsq; float scale, pad_;
    __device__ __forceinline__ void operator()(const pg8::f32x4 (&acc)[2][2][4][2], const pg8::Unit& u, int wr, int wc, int fr, int fq) const {
        int oz; asm volatile("v_mov_b32 %0, 0" : "=v"(oz));
        const int row0 = u.pm * 256 + wr * 64 + fr + oz, col0 = u.pn * 256 + wc * 32 + 4 * fq;
        const float* gp = gn ? gn : base;
        f32x4 g4[2][2];
#pragma unroll
        for (int bj = 0; bj < 2; ++bj)
#pragma unroll
            for (int n = 0; n < 2; ++n) g4[bj][n] = *(const f32x4*)(gp + col0 + bj * 128 + n * 16);
#pragma unroll
        for (int ai = 0; ai < 2; ++ai) {
            f32x4 bv[4][2][2];
#pragma unroll
            for (int m = 0; m < 4; ++m)
#pragma unroll
                for (int bj = 0; bj < 2; ++bj)
#pragma unroll
                    for (int n = 0; n < 2; ++n) bv[m][bj][n] = *(const f32x4*)(base + (size_t)(row0 + ai * 128 + m * 16) * DM + col0 + bj * 128 + n * 16);
            asm volatile("" ::: "memory");
#pragma unroll
            for (int m = 0; m < 4; ++m) {
                const int row = row0 + ai * 128 + m * 16;
                const size_t ro = (size_t)row * DM + col0;
                float ss = 0.f;
#pragma unroll
                for (int bj = 0; bj < 2; ++bj)
#pragma unroll
                    for (int n = 0; n < 2; ++n) {
                        const size_t off = ro + bj * 128 + n * 16;
                        f32x4 a; a.x = acc[ai][bj][m][n][0]; a.y = acc[ai][bj][m][n][1]; a.z = acc[ai][bj][m][n][2]; a.w = acc[ai][bj][m][n][3];
                        const f32x4 v = bv[m][bj][n] + a * scale;
                        *(f32x4*)(out + off) = v;
                        if (gn) { *(u32x2*)(XN + off) = pk4(v * g4[bj][n]); ss += (v.x * v.x + v.y * v.y) + (v.z * v.z + v.w * v.w); }
                    }
                if (gn) { ss = fq_sum(ss); if (fq == 0) rsq[(size_t)row * 16 + u.pn * 4 + wc] = ss; }
            }
        }
    }
};
struct EpiStore {
    static constexpr bool PERM = true, AFTER_DRAIN = false;
    bf16* O; int ldc; const float* rsq;
    __device__ __forceinline__ void operator()(const pg8::f32x4 (&acc)[2][2][4][2], const pg8::Unit& u, int wr, int wc, int fr, int fq) const {
        int oz; asm volatile("v_mov_b32 %0, 0" : "=v"(oz));
        const int row0 = u.pm * 256 + wr * 64 + fr + oz, col0 = u.pn * 256 + wc * 32 + 8 * fq;
        float rs8[8]; row_rstd8(rsq, row0, fq, rs8);
#pragma unroll
        for (int ai = 0; ai < 2; ++ai)
#pragma unroll
            for (int m = 0; m < 4; ++m) {
                bf16* p = O + (size_t)(row0 + ai * 128 + m * 16) * ldc + col0;
                const float r = rs8[ai * 4 + m];
#pragma unroll
                for (int bj = 0; bj < 2; ++bj) {
                    u32x4 w; w.x = pk2(acc[ai][bj][m][0][0] * r, acc[ai][bj][m][0][1] * r); w.y = pk2(acc[ai][bj][m][0][2] * r, acc[ai][bj][m][0][3] * r);
                    w.z = pk2(acc[ai][bj][m][1][0] * r, acc[ai][bj][m][1][1] * r); w.w = pk2(acc[ai][bj][m][1][2] * r, acc[ai][bj][m][1][3] * r);
                    __builtin_nontemporal_store(w, (u32x4*)(p + bj * 128));
                }
            }
    }
};
__device__ __forceinline__ float decay_f(float x) {
    const float y = -x, sp = fmaxf(y, 0.f) + __builtin_amdgcn_logf(1.0f + fexp(-fabsf(y))) * 0.6931471805599453f;
    return fexp(-fexp(-sp - 0.5f));
}

struct EpiLowRank {
    static constexpr bool PERM = true, AFTER_DRAIN = false;
    float* W; bf16* Aa; bf16* G; const float* w0; const float* a0;
    __device__ __forceinline__ void operator()(const pg8::f32x4 (&acc)[2][2][4][2], const pg8::Unit& u, int wr, int wc, int fr, int fq) const {
        const int region = u.pn >> 1;
        int oz; asm volatile("v_mov_b32 %0, 0" : "=v"(oz));
        const int row0 = u.pm * 256 + wr * 64 + fr + oz, col0 = (u.pn & 1) * 256 + wc * 32 + 8 * fq;
        bf16* OB = region == 1 ? Aa : G;
        const float* bp = region == 0 ? w0 : a0;
#pragma unroll
        for (int bj = 0; bj < 2; ++bj) {
            f32x4 b0 = {0.f, 0.f, 0.f, 0.f}, b1 = b0;
            if (region < 2) { b0 = *(const f32x4*)(bp + col0 + bj * 128); b1 = *(const f32x4*)(bp + col0 + bj * 128 + 4); }
#pragma unroll
            for (int ai = 0; ai < 2; ++ai)
#pragma unroll
                for (int m = 0; m < 4; ++m) {
                    const size_t off = (size_t)(row0 + ai * 128 + m * 16) * 512 + col0 + bj * 128;
                    f32x4 v0 = (f32x4){acc[ai][bj][m][0][0], acc[ai][bj][m][0][1], acc[ai][bj][m][0][2], acc[ai][bj][m][0][3]} + b0;
                    f32x4 v1 = (f32x4){acc[ai][bj][m][1][0], acc[ai][bj][m][1][1], acc[ai][bj][m][1][2], acc[ai][bj][m][1][3]} + b1;
                    if (region == 0) {
                        *(f32x4*)(W + off) = (f32x4){decay_f(v0.x), decay_f(v0.y), decay_f(v0.z), decay_f(v0.w)};
                        *(f32x4*)(W + off + 4) = (f32x4){decay_f(v1.x), decay_f(v1.y), decay_f(v1.z), decay_f(v1.w)};
                    } else {
                        if (region == 1) { v0 = (f32x4){fsigmoid(v0.x), fsigmoid(v0.y), fsigmoid(v0.z), fsigmoid(v0.w)}; v1 = (f32x4){fsigmoid(v1.x), fsigmoid(v1.y), fsigmoid(v1.z), fsigmoid(v1.w)}; }
                        u32x4 w; w.x = pk2(v0.x, v0.y); w.y = pk2(v0.z, v0.w); w.z = pk2(v1.x, v1.y); w.w = pk2(v1.z, v1.w);
                        *(u32x4*)(OB + off) = w;
                    }
                    asm volatile("" ::: "memory");
                }
        }
    }
};

template <class Epi> __device__ __forceinline__ void run_gemm(LAS unsigned char* lds, const bf16* A, const bf16* Bt, int N, int K, const Epi& E) {
    asm volatile("" : "+s"(N), "+s"(K));
    pg8::Gemm g{A, Bt, T, N, K}; pg8::StaticOrder S; S.init(T, N, (int)gridDim.x, (int)blockIdx.x);
    pg8::gemm_phase<Epi, pg8::StaticOrder, true, true>(lds, g, S, E);
}

__device__ __forceinline__ void transpose_item(const float* W, int K, int N, bf16* WT, int mode, LAS float* scr, int item, int lane) {
    const int nblk = N / 32, kb = item / nblk, nb = item % nblk, k0 = 64 * kb, n0 = 32 * nb;
    int drow0 = n0; if (mode) drow0 = 256 * (n0 >> 7) + (n0 & 127) + (mode == 2 ? 128 : 0);
    float tv[32];
#pragma unroll
    for (int i = 0; i < 32; ++i) tv[i] = W[(size_t)(k0 + 2 * i + (lane >> 5)) * N + n0 + (lane & 31)];
#pragma unroll
    for (int i = 0; i < 32; ++i) scr[(2 * i + (lane >> 5)) * 33 + (lane & 31)] = tv[i];
    asm volatile("s_waitcnt lgkmcnt(0)" ::: "memory");
    const int c = lane & 7;
#pragma unroll
    for (int j = 0; j < 4; ++j) { const int n = (lane >> 3) + 8 * j; const LAS float* s = scr + (8 * c) * 33 + n;
        u32x4 o; o.x = pk2(s[0 * 33], s[1 * 33]); o.y = pk2(s[2 * 33], s[3 * 33]); o.z = pk2(s[4 * 33], s[5 * 33]); o.w = pk2(s[6 * 33], s[7 * 33]);
        *(u32x4*)(WT + (size_t)(drow0 + n) * K + k0 + 8 * c) = o; }
    asm volatile("s_waitcnt lgkmcnt(0)" ::: "memory");
}

__device__ __forceinline__ void transpose_load(const float* W, int K, int N, int item, int lane, float (&tv)[32]) {
    const int nblk = N / 32, kb = item / nblk, nb = item % nblk, k0 = 64 * kb, n0 = 32 * nb;
#pragma unroll
    for (int i = 0; i < 32; ++i) tv[i] = W[(size_t)(k0 + 2 * i + (lane >> 5)) * N + n0 + (lane & 31)];
}
__device__ __forceinline__ void transpose_store(int K, int N, bf16* WT, int mode, LAS float* scr, int item, int lane, const float (&tv)[32]) {
    const int nblk = N / 32, kb = item / nblk, nb = item % nblk, k0 = 64 * kb, n0 = 32 * nb;
    int drow0 = n0; if (mode) drow0 = 256 * (n0 >> 7) + (n0 & 127) + (mode == 2 ? 128 : 0);
#pragma unroll
    for (int i = 0; i < 32; ++i) scr[(2 * i + (lane >> 5)) * 33 + (lane & 31)] = tv[i];
    asm volatile("s_waitcnt lgkmcnt(0)" ::: "memory");
    const int c = lane & 7;
#pragma unroll
    for (int j = 0; j < 4; ++j) { const int n = (lane >> 3) + 8 * j; const LAS float* sp = scr + (8 * c) * 33 + n;
        u32x4 o; o.x = pk2(sp[0 * 33], sp[1 * 33]); o.y = pk2(sp[2 * 33], sp[3 * 33]); o.z = pk2(sp[4 * 33], sp[5 * 33]); o.w = pk2(sp[6 * 33], sp[7 * 33]);
        *(u32x4*)(WT + (size_t)(drow0 + n) * K + k0 + 8 * c) = o; }
    asm volatile("s_waitcnt lgkmcnt(0)" ::: "memory");
}
constexpr int DI_GU = 16 * 88, DI_D = 44 * 32, DI_SQ = 16 * 32, DI_CIN = 16 * 96;
constexpr int DEFER_ITEMS = 6 * DI_GU + 3 * DI_D + DI_SQ + DI_CIN + DI_SQ;
struct DeferItem { const float* W; bf16* WT; int K, N, mode, item; };
__device__ __forceinline__ DeferItem defer_decode(const Args& a, int it) {
    DeferItem d; unsigned char* ws = a.ws; int r = it;
    if (r < 6 * DI_GU) { const int f = 1 + r / (2 * DI_GU), which = (r / DI_GU) & 1;
        d.W = (which ? a.in[3] : a.in[2]) + (size_t)f * DM * DFF; d.WT = (bf16*)(ws + WS_WGU + f * WGU_STRIDE); d.K = DM; d.N = DFF; d.mode = 1 + which; d.item = r % DI_GU; return d; }
    r -= 6 * DI_GU;
    if (r < 3 * DI_D) { const int f = 1 + r / DI_D; d.W = a.in[4] + (size_t)f * DFF * DM; d.WT = (bf16*)(ws + WS_WD + f * WD_STRIDE); d.K = DFF; d.N = DM; d.mode = 0; d.item = r % DI_D; return d; }
    r -= 3 * DI_D;
    if (r < DI_SQ) { d.W = a.in[23]; d.WT = (bf16*)(ws + WS_WEOUT); d.K = DM; d.N = DM; d.mode = 0; d.item = r; return d; } r -= DI_SQ;
    if (r < DI_CIN) { d.W = a.in[24]; d.WT = (bf16*)(ws + WS_WCIN); d.K = DM; d.N = Z3W; d.mode = 0; d.item = r; return d; } r -= DI_CIN;
    d.W = a.in[32]; d.WT = (bf16*)(ws + WS_WCOUT); d.K = DM; d.N = DM; d.mode = 0; d.item = r; return d;
}

__device__ __forceinline__ void rmsnorm_phase(const float* X, const float* g, bf16* XN, int gw, int NGW, int lane) {
    f32x4 gv[4];
#pragma unroll
    for (int j = 0; j < 4; ++j) gv[j] = *(const f32x4*)(g + 4 * lane + 256 * j);
#pragma unroll 4
    for (int m = gw; m < T; m += NGW) {
        const f32x4* xr = (const f32x4*)(X + (size_t)m * DM) + lane;
        f32x4 v[4]; float s = 0.f;
#pragma unroll
        for (int j = 0; j < 4; ++j) { v[j] = xr[64 * j]; s += (v[j].x * v[j].x + v[j].y * v[j].y) + (v[j].z * v[j].z + v[j].w * v[j].w); }
        const float rstd = rsqrtf(wave_sum(s) * (1.f / DM) + 1e-6f);
        u32x2* o8 = (u32x2*)(XN + (size_t)m * DM) + lane;
#pragma unroll
        for (int j = 0; j < 4; ++j) o8[64 * j] = pk4(v[j] * rstd * gv[j]);
    }
}

__device__ __forceinline__ void prologue_phase(const Args& a, LAS unsigned char* lds, int tid, int lane, int wave) {
    unsigned char* ws = a.ws;
    LAS float* scr = (LAS float*)(lds + wave * 16384);
    const int gw = blockIdx.x * NWAVES + wave, NGW = gridDim.x * NWAVES;
    constexpr int I_GU = 16 * 88, I_D = 44 * 32, I_AIN = 16 * 88;
    constexpr int NITEMS = 2 * I_GU + I_D + I_AIN;
    for (int it = gw; it < NITEMS; it += NGW) {
        int r = it;
        if (r < 2 * I_GU) { const int which = r / I_GU, i = r % I_GU; transpose_item(which ? a.in[3] : a.in[2], DM, DFF, (bf16*)(ws + WS_WGU), 1 + which, scr, i, lane); continue; }
        r -= 2 * I_GU;
        if (r < I_D) { transpose_item(a.in[4], DFF, DM, (bf16*)(ws + WS_WD), 0, scr, r, lane); continue; }
        r -= I_D;
        transpose_item(a.in[6], DM, ZW, (bf16*)(ws + WS_WAIN), 0, scr, r, lane);
    }
    {
        bf16* BD = (bf16*)(ws + WS_WBD);
        const int gt = blockIdx.x * NTHR + tid, NGT = gridDim.x * NTHR;
        for (int i = gt; i < 1536 * 256; i += NGT) {
            const int n = i >> 8, k = i & 255; float v = 0.f;
            if (n < 512) { if (k < 64) v = a.in[9][k * 512 + n]; }
            else if (n < 1024) { if (k >= 64 && k < 128) v = a.in[11][(k - 64) * 512 + (n - 512)]; }
            else { if (k >= 128) v = a.in[12][(k - 128) * 512 + (n - 1024)]; }
            BD[i] = (bf16)(pk2(v, 0.f) & 0xffffu);
        }
        float* COS = (float*)(ws + WS_ROPE); float* SIN = COS + SEQ * 32;
        for (int i = gt; i < SEQ * 32; i += NGT) {
            const int s = i >> 5, j = i & 31;
            const float ang = (float)s * ROPE_INV[j];
            double rev = (double)ang * 0.15915494309189535; rev -= floor(rev);
            COS[i] = __builtin_amdgcn_cosf((float)rev); SIN[i] = __builtin_amdgcn_sinf((float)rev);
        }
        if (blockIdx.x == 0 && wave == 0) {
            const float s1 = wave_sum(a.in[27][lane] * a.in[28][lane]), s2 = wave_sum(a.in[29][lane] * a.in[30][lane]);
            if (lane == 0) *(float*)(ws + WS_LAM) = expf(s1) - expf(s2) + LAM_INIT;
        }
    }
    rmsnorm_phase(a.in[0], a.in[1], (bf16*)(ws + WS_XN), gw, NGW, lane);
}

__device__ __forceinline__ void e1_phase(const bf16* Z, const float* mu, bf16* LR, int tid) {
    const int seg = tid & 31, col = 1536 + 8 * seg;
    float muv[8];
#pragma unroll
    for (int e = 0; e < 8; ++e) muv[e] = mu[col + e];
#pragma unroll 2
    for (int it = blockIdx.x; it < T / 16; it += gridDim.x) {
        const int m = it * 16 + (tid >> 5), s = m & (SEQ - 1);
        const u32x4 zc = *(const u32x4*)(Z + (size_t)m * ZW + col);
        u32x4 zp = {0u, 0u, 0u, 0u}; if (s) zp = *(const u32x4*)(Z + (size_t)(m - 1) * ZW + col);
        float v[8];
#pragma unroll
        for (int e = 0; e < 4; ++e) { const float c0 = bflo(zc[e]), c1 = bfhi(zc[e]), p0 = bflo(zp[e]), p1 = bfhi(zp[e]);
            v[2 * e] = c0 + (p0 - c0) * muv[2 * e]; v[2 * e + 1] = c1 + (p1 - c1) * muv[2 * e + 1]; }
        if (seg < 8) {
#pragma unroll
            for (int e = 0; e < 8; ++e) v[e] = ftanh(v[e]);
        } else if (seg >= 16) {
#pragma unroll
            for (int e = 0; e < 8; ++e) v[e] = fsigmoid(v[e]);
        }
        u32x4 w; w.x = pk2(v[0], v[1]); w.y = pk2(v[2], v[3]); w.z = pk2(v[4], v[5]); w.w = pk2(v[6], v[7]);
        *(u32x4*)(LR + (size_t)m * 256 + 8 * seg) = w;
    }
}
__device__ __forceinline__ void e2_phase(const Args& a, const bf16* Z, bf16* Aa, float* W, bf16* KK, float* BON, int gw, int NGW, int lane) {
    const float* mu = a.in[7];
    const int half = gw & 1, c = half * 256 + 4 * lane, h = c >> 6;
    const f32x4 mur = *(const f32x4*)(mu + c), muk = *(const f32x4*)(mu + 512 + c), kkw = *(const f32x4*)(a.in[13] + c), kaw = *(const f32x4*)(a.in[14] + c), rkw = *(const f32x4*)(a.in[15] + c), a0w = *(const f32x4*)(a.in[10] + c), w0w = *(const f32x4*)(a.in[8] + c);
    const int MS = NGW >> 1;
    for (int mb = gw >> 1; mb < T; mb += 4 * MS) {
        u32x2 zr[4], zk[4], zrp[4], zkp[4], za[4];
#pragma unroll
        for (int i = 0; i < 4; ++i) {
            const int m = mb + i * MS; const bool ok = m < T; const int mm = ok ? m : 0, s = mm & (SEQ - 1);
            const bf16* zp = Z + (size_t)mm * ZW + c;
            zr[i] = *(const u32x2*)zp; zk[i] = *(const u32x2*)(zp + 512); za[i] = *(const u32x2*)(Aa + (size_t)mm * 512 + c);
            const bf16* zq = s ? zp - ZW : zp;
            zrp[i] = *(const u32x2*)zq; zkp[i] = *(const u32x2*)(zq + 512);
            if (!s) { zrp[i] = (u32x2){0u, 0u}; zkp[i] = zrp[i]; }
        }
#pragma unroll
        for (int i = 0; i < 4; ++i) {
            const int m = mb + i * MS; if (m >= T) break;
            const f32x4 rc = bf4(zr[i]), kc = bf4(zk[i]), rp = bf4(zrp[i]), kp = bf4(zkp[i]), av = bf4(za[i]);
            const f32x4 r = rc + (rp - rc) * mur, k = kc + (kp - kc) * muk;
            const f32x4 kr = k * kkw;
            const float ss = red16((kr.x * kr.x + kr.y * kr.y) + (kr.z * kr.z + kr.w * kr.w));
            const float inv = 1.0f / fmaxf(sqrtf(ss), 1e-12f);
            const f32x4 kt = k * (1.0f + (av - 1.0f) * kaw);
            const f32x4 bb = r * kt * rkw;
            const float bon = red16((bb.x + bb.y) + (bb.z + bb.w));
            *(u32x2*)(KK + (size_t)m * 512 + c) = pk4(kr * inv);
            if ((lane & 15) == 0) BON[m * 8 + h] = bon;
        }
    }
}

constexpr int SCH = 32, SROW = 336;
__device__ __forceinline__ void scan_phase(const Args& a, LAS unsigned char* lds, const bf16* Z, const float* W, const bf16* Aa, const bf16* KK, float* Y, int tid, int lane, int wave) {
    const float* mu = a.in[7];
    LAS float* buf = (LAS float*)lds;
    const int lt = tid & 255, step0 = lt >> 4, seg = lt & 15;
    const bool loader = wave >= 4;
    for (int u = blockIdx.x; u < 256; u += gridDim.x) {
        const int bh = (u & 7) + 8 * (u >> 5), rg = (u >> 3) & 3, b = bh >> 3, h = bh & 7;
        const int c = h * 64 + 4 * seg;
        const int cv = h * 64 + rg * 16 + 4 * (seg & 3);
        const f32x4 mur = *(const f32x4*)(mu + c), muk = *(const f32x4*)(mu + 512 + c), muv = *(const f32x4*)(mu + 1024 + cv), kaw = *(const f32x4*)(a.in[14] + c);
        const size_t m0 = (size_t)b * SEQ;
        u32x2 zr[2], zrp[2], zk[2], zkp[2], zv[2], zvp[2], kk4[2], a4[2]; f32x4 w4[2];
#pragma unroll
        for (int i = 0; i < 2; ++i) { zv[i] = (u32x2){0u, 0u}; zvp[i] = zv[i]; }
#define SCAN_LOAD1(t0, i) do { const int t_ = (t0) + step0 + 16 * (i); const size_t m_ = m0 + t_; const bf16* zp_ = Z + m_ * ZW; \
            zr[i] = *(const u32x2*)(zp_ + c); zk[i] = *(const u32x2*)(zp_ + 512 + c); if (seg < 4) zv[i] = *(const u32x2*)(zp_ + 1024 + cv); \
            if (t_ > 0) { zrp[i] = *(const u32x2*)(zp_ - ZW + c); zkp[i] = *(const u32x2*)(zp_ - ZW + 512 + c); if (seg < 4) zvp[i] = *(const u32x2*)(zp_ - ZW + 1024 + cv); } \
            else { zrp[i] = (u32x2){0u, 0u}; zkp[i] = zrp[i]; zvp[i] = zrp[i]; } \
            kk4[i] = *(const u32x2*)(KK + m_ * 512 + c); a4[i] = *(const u32x2*)(Aa + m_ * 512 + c); w4[i] = *(const f32x4*)(W + m_ * 512 + c); } while (0)
#define SCAN_STORE1(bi, i) do { LAS float* d_ = buf + (bi) * (SCH * SROW) + (step0 + 16 * (i)) * SROW + 4 * seg; \
            const f32x4 rc_ = bf4(zr[i]), rp_ = bf4(zrp[i]), kc_ = bf4(zk[i]), kp_ = bf4(zkp[i]), av_ = bf4(a4[i]), kkv_ = bf4(kk4[i]), wd_ = w4[i]; \
            const f32x4 r_ = rc_ + (rp_ - rc_) * mur, k_ = kc_ + (kp_ - kc_) * muk; \
            *(LAS f32x4*)(d_) = wd_; *(LAS f32x4*)(d_ + 64) = k_ * (1.0f + (av_ - 1.0f) * kaw); *(LAS f32x4*)(d_ + 128) = -kkv_; *(LAS f32x4*)(d_ + 192) = kkv_ * av_; *(LAS f32x4*)(d_ + 256) = r_; \
            if (seg < 4) { const f32x4 vc_ = bf4(zv[i]), vp_ = bf4(zvp[i]); *(LAS f32x4*)(d_ + 320) = vc_ + (vp_ - vc_) * muv; } } while (0)
#define SCAN_LOAD(t0) do { SCAN_LOAD1(t0, 0); SCAN_LOAD1(t0, 1); } while (0)
#define SCAN_STORE(bi) do { SCAN_STORE1(bi, 0); SCAN_STORE1(bi, 1); } while (0)
        if (loader) { SCAN_LOAD(0); SCAN_STORE(0); SCAN_LOAD(SCH); }
        lds_barrier();
        f32x2 S01 = {0.f, 0.f}, S23 = {0.f, 0.f};
        const bool dfirst = (u == (int)blockIdx.x);
        const int NL = gridDim.x * 4, gl = blockIdx.x * 4 + (wave - 4);
        LAS float* dscr = (LAS float*)(lds + 90112 + (wave & 3) * 8448);
        float dtv[32];
#pragma unroll
        for (int i = 0; i < 32; ++i) dtv[i] = 0.f;
        const bool consumer = wave < 4;
        const int j = lane & 15, ri = 4 * wave + (lane >> 4);
        float* yp = Y + m0 * 512 + h * 64 + rg * 16 + ri;
        for (int ch = 0; ch < SEQ / SCH; ++ch) {
            if (loader) {
                if (ch + 1 < SEQ / SCH) SCAN_STORE((ch + 1) & 1);
                if (ch + 2 < SEQ / SCH) SCAN_LOAD((ch + 2) * SCH);
                if (dfirst) {
                    const int dit = gl + (ch >> 3) * NL;
                    if (dit < DEFER_ITEMS) {
                        if ((ch & 7) == 1) { const DeferItem d = defer_decode(a, dit); transpose_load(d.W, d.K, d.N, d.item, lane, dtv); }
                        else if ((ch & 7) == 2) { const DeferItem d = defer_decode(a, dit); transpose_store(d.K, d.N, d.WT, d.mode, dscr, d.item, lane, dtv); }
                    }
                }
            }
            if (consumer) {
                const LAS float* sb = buf + (ch & 1) * (SCH * SROW) + 4 * j;
                const LAS float* vb = buf + (ch & 1) * (SCH * SROW) + 320 + ri;
                f32x4 pw[3], pk[3], pa[3], pb[3], pr[3]; float pv[3];
#pragma unroll
                for (int i = 0; i < 2; ++i) { const LAS float* p = sb + i * SROW;
                    pw[i] = *(const LAS f32x4*)p; pk[i] = *(const LAS f32x4*)(p + 64); pa[i] = *(const LAS f32x4*)(p + 128); pb[i] = *(const LAS f32x4*)(p + 192); pr[i] = *(const LAS f32x4*)(p + 256); pv[i] = vb[i * SROW]; }
                float ykA = 0.f, ykB = 0.f, yd = 0.f;
#pragma unroll
                for (int q = 0; q < SCH; ++q) {
                    const f32x4 wv = pw[q % 3], kv = pk[q % 3], av = pa[q % 3], bv = pb[q % 3], rv = pr[q % 3]; const float vv = pv[q % 3];
                    if (q + 2 < SCH) {
                        const LAS float* p = sb + (q + 2) * SROW; const int i = (q + 2) % 3;
                        pw[i] = *(const LAS f32x4*)p; pk[i] = *(const LAS f32x4*)(p + 64); pa[i] = *(const LAS f32x4*)(p + 128); pb[i] = *(const LAS f32x4*)(p + 192); pr[i] = *(const LAS f32x4*)(p + 256);
                        pv[i] = vb[(q + 2) * SROW];
                    }
                    f32x2 t2 = S01 * (f32x2){av.x, av.y}; t2 = S23 * (f32x2){av.z, av.w} + t2;
                    float sa = t2.x + t2.y;
                    sa += dppf<0xB1>(sa); yd += dppf<0xB1>(yd);
                    sa += dppf<0x4E>(sa); yd += dppf<0x4E>(yd);
                    sa += dppf<0x141>(sa); yd += dppf<0x141>(yd);
                    sa += dppf<0x140>(sa); yd += dppf<0x140>(yd);
                    if (q > 0) { if (q <= 16) ykA = (j == q - 1) ? yd : ykA; else ykB = (j == q - 17) ? yd : ykB; }
                    const f32x2 u01 = S01 * (f32x2){wv.x, wv.y} + (f32x2){kv.x, kv.y} * vv, u23 = S23 * (f32x2){wv.z, wv.w} + (f32x2){kv.z, kv.w} * vv;
                    S01 = u01 + (f32x2){bv.x, bv.y} * sa; S23 = u23 + (f32x2){bv.z, bv.w} * sa;
                    f32x2 y2 = S01 * (f32x2){rv.x, rv.y}; y2 = S23 * (f32x2){rv.z, rv.w} + y2;
                    yd = y2.x + y2.y;
                }
                yd = red16(yd); ykB = (j == 15) ? yd : ykB;
                yp[(size_t)(ch * SCH + j) * 512] = ykA;
                yp[(size_t)(ch * SCH + 16 + j) * 512] = ykB;
            }
            lds_barrier();
        }
        if (loader && dfirst) {
            for (int dit = gl + (SEQ / SCH / 8) * NL; dit < DEFER_ITEMS; dit += NL) { const DeferItem d = defer_decode(a, dit); transpose_load(d.W, d.K, d.N, d.item, lane, dtv); transpose_store(d.K, d.N, d.WT, d.mode, dscr, d.item, lane, dtv); }
        }
#undef SCAN_LOAD
#undef SCAN_STORE
#undef SCAN_LOAD1
#undef SCAN_STORE1
    }
}

__device__ __forceinline__ void e3_phase(const Args& a, LAS unsigned char* lds, const bf16* Z, const float* Y, const float* BON, const bf16* G, bf16* YC, int tid, int lane, int wave) {
    const int gw = blockIdx.x * NWAVES + wave, NGW = gridDim.x * NWAVES;
    {
        const int half = gw & 1, c = half * 256 + 4 * lane, h = c >> 6;
        const f32x4 muv = *(const f32x4*)(a.in[7] + 1024 + c), lw = *(const f32x4*)(a.in[16] + c), lb = *(const f32x4*)(a.in[17] + c);
        const int MS = NGW >> 1;
        for (int mb = gw >> 1; mb < T; mb += 4 * MS) {
            f32x4 yv[4]; u32x2 zv[4], zvp[4], gv[4]; float bn[4];
#pragma unroll
            for (int i = 0; i < 4; ++i) {
                const int m = mb + i * MS; const bool ok = m < T; const int mm = ok ? m : 0, s = mm & (SEQ - 1);
                yv[i] = *(const f32x4*)(Y + (size_t)mm * 512 + c);
                const bf16* zp = Z + (size_t)mm * ZW + 1024 + c;
                zv[i] = *(const u32x2*)zp; zvp[i] = *(const u32x2*)(s ? zp - ZW : zp); if (!s) zvp[i] = (u32x2){0u, 0u};
                gv[i] = *(const u32x2*)(G + (size_t)mm * 512 + c); bn[i] = BON[mm * 8 + h];
            }
#pragma unroll
            for (int i = 0; i < 4; ++i) {
                const int m = mb + i * MS; if (m >= T) break;
                const f32x4 y = yv[i], vc = bf4(zv[i]), vp = bf4(zvp[i]), g = bf4(gv[i]);
                const float mean = red16((y.x + y.y) + (y.z + y.w)) * (1.f / 64.f);
                const f32x4 d = y - mean;
                const float var = red16((d.x * d.x + d.y * d.y) + (d.z * d.z + d.w * d.w)) * (1.f / 64.f);
                const f32x4 yn = d * rsqrtf(var + 64e-5f) * lw + lb;
                const f32x4 v = vc + (vp - vc) * muv;
                *(u32x2*)(YC + (size_t)m * DM + c) = pk4((yn + v * bn[i]) * g);
            }
        }
    }
    {
        LAS float* gl = (LAS float*)lds;
        const int ch = tid;
        const int sr = tid >> 6, sseg = tid & 63;
        f32x4 gb1a = *(const f32x4*)(a.in[18] + 8 * sseg), gb1b = *(const f32x4*)(a.in[18] + 8 * sseg + 4), gb2a = *(const f32x4*)(a.in[18] + 512 + 8 * sseg), gb2b = *(const f32x4*)(a.in[18] + 512 + 8 * sseg + 4);
        const float dwb = a.in[20][ch];
        float dw[31];
#pragma unroll
        for (int j = 0; j < 31; ++j) dw[j] = a.in[19][j * 512 + ch];
        const f32x4 cw0 = *(const f32x4*)(a.in[21] + 4 * lane), cw1 = *(const f32x4*)(a.in[21] + 256 + 4 * lane), cb0 = *(const f32x4*)(a.in[22] + 4 * lane), cb1 = *(const f32x4*)(a.in[22] + 256 + 4 * lane);
        for (int tile = blockIdx.x; tile < T / 32; tile += gridDim.x) {
            const int m0 = tile * 32, s0 = m0 & (SEQ - 1);
            u32x4 r1[8], r2[8];
#pragma unroll
            for (int i = 0; i < 8; ++i) {
                const int tt = 8 * i + sr, s = s0 - 30 + tt; const bool ok = tt < 62 && s >= 0;
                const bf16* zp = Z + (size_t)(ok ? m0 - 30 + tt : m0) * ZW + 1792 + 8 * sseg;
                r1[i] = *(const u32x4*)zp; r2[i] = *(const u32x4*)(zp + 512);
            }
#pragma unroll
            for (int i = 0; i < 8; ++i) {
                const int tt = 8 * i + sr, s = s0 - 30 + tt;
                if (tt < 62) {
                    f32x4 o0, o1;
                    if (s >= 0) {
                        const f32x4 u1a = (f32x4){bflo(r1[i].x), bfhi(r1[i].x), bflo(r1[i].y), bfhi(r1[i].y)} + gb1a, u1b = (f32x4){bflo(r1[i].z), bfhi(r1[i].z), bflo(r1[i].w), bfhi(r1[i].w)} + gb1b;
                        const f32x4 u2a = (f32x4){bflo(r2[i].x), bfhi(r2[i].x), bflo(r2[i].y), bfhi(r2[i].y)} + gb2a, u2b = (f32x4){bflo(r2[i].z), bfhi(r2[i].z), bflo(r2[i].w), bfhi(r2[i].w)} + gb2b;
                        o0 = (f32x4){u1a.x * fsigmoid(u2a.x), u1a.y * fsigmoid(u2a.y), u1a.z * fsigmoid(u2a.z), u1a.w * fsigmoid(u2a.w)};
                        o1 = (f32x4){u1b.x * fsigmoid(u2b.x), u1b.y * fsigmoid(u2b.y), u1b.z * fsigmoid(u2b.z), u1b.w * fsigmoid(u2b.w)};
                    } else { o0 = (f32x4){0.f, 0.f, 0.f, 0.f}; o1 = o0; }
                    *(LAS f32x4*)(gl + tt * 512 + 8 * sseg) = o0; *(LAS f32x4*)(gl + tt * 512 + 8 * sseg + 4) = o1;
                }
            }
            __syncthreads();
            {
                float gv[62];
#pragma unroll
                for (int i = 0; i < 62; ++i) gv[i] = gl[i * 512 + ch];
#pragma unroll
                for (int t = 0; t < 32; ++t) {
                    float acc = dwb;
#pragma unroll
                    for (int j = 0; j < 31; ++j) acc += gv[t + j] * dw[j];
                    gl[t * 512 + ch] = acc;
                }
            }
            __syncthreads();
#pragma unroll
            for (int q = 0; q < 4; ++q) {
                const int t = 4 * wave + q;
                const f32x4 x0 = *(const LAS f32x4*)(gl + t * 512 + 4 * lane), x1 = *(const LAS f32x4*)(gl + t * 512 + 256 + 4 * lane);
                const float mean = wave_sum((x0.x + x0.y) + (x0.z + x0.w) + (x1.x + x1.y) + (x1.z + x1.w)) * (1.f / 512.f);
                const f32x4 d0 = x0 - mean, d1 = x1 - mean;
                const float var = wave_sum((d0.x * d0.x + d0.y * d0.y) + (d0.z * d0.z + d0.w * d0.w) + (d1.x * d1.x + d1.y * d1.y) + (d1.z * d1.z + d1.w * d1.w)) * (1.f / 512.f);
                const float rs = rsqrtf(var + 1e-5f);
                f32x4 y0 = d0 * rs * cw0 + cb0, y1 = d1 * rs * cw1 + cb1;
                y0.x *= fsigmoid(y0.x); y0.y *= fsigmoid(y0.y); y0.z *= fsigmoid(y0.z); y0.w *= fsigmoid(y0.w);
                y1.x *= fsigmoid(y1.x); y1.y *= fsigmoid(y1.y); y1.z *= fsigmoid(y1.z); y1.w *= fsigmoid(y1.w);
                bf16* o = YC + (size_t)(m0 + t) * DM + 512 + 4 * lane;
                *(u32x2*)o = pk4(y0); *(u32x2*)(o + 256) = pk4(y1);
            }
            __syncthreads();
        }
    }
}

__device__ __forceinline__ void qkrope_phase(const Args& a, LAS unsigned char* lds, const bf16* Z3, bf16* Qn, bf16* Kn, bf16* Vt, int tid, int lane, int wave) {
    const int gw = blockIdx.x * NWAVES + wave, NGW = gridDim.x * NWAVES;
    const float* COS = (const float*)(a.ws + WS_ROPE); const float* SIN = COS + SEQ * 32;
    {
        const int part = gw & 3, isk = part >> 1, grp = lane >> 3, j = lane & 7, gi = (part & 1) * 8 + grp, h = gi >> 1, c = gi & 1;
        const int col0 = isk * 1024 + gi * 64 + 4 * j;
        const float* nw = a.in[isk ? 26 : 25];
        const f32x4 n1 = *(const f32x4*)(nw + 4 * j), n2 = *(const f32x4*)(nw + 32 + 4 * j);
        const float sc = isk ? 1.0f : QSCALE;
        bf16* dstb = isk ? Kn : Qn;
        const int MS = NGW >> 2;
        for (int mb = gw >> 2; mb < T; mb += 4 * MS) {
            u32x2 z1[4], z2[4]; f32x4 csv[4], snv[4];
#pragma unroll
            for (int i = 0; i < 4; ++i) {
                const int m = mb + i * MS; const int mm = m < T ? m : 0, s = mm & (SEQ - 1);
                const bf16* zp = Z3 + (size_t)mm * Z3W + col0;
                z1[i] = *(const u32x2*)zp; z2[i] = *(const u32x2*)(zp + 32);
                csv[i] = *(const f32x4*)(COS + s * 32 + 4 * j); snv[i] = *(const f32x4*)(SIN + s * 32 + 4 * j);
            }
#pragma unroll
            for (int i = 0; i < 4; ++i) {
                const int m = mb + i * MS; if (m >= T) break;
                const int b = m >> 12, s = m & (SEQ - 1);
                f32x4 x1 = bf4(z1[i]), x2 = bf4(z2[i]);
                const float ss = red8((x1.x * x1.x + x1.y * x1.y) + (x1.z * x1.z + x1.w * x1.w) + (x2.x * x2.x + x2.y * x2.y) + (x2.z * x2.z + x2.w * x2.w));
                const float rs = rsqrtf(ss * (1.f / 64.f) + 1e-6f);
                x1 = x1 * rs * n1; x2 = x2 * rs * n2;
                const f32x4 o1 = (x1 * csv[i] - x2 * snv[i]) * sc, o2 = (x2 * csv[i] + x1 * snv[i]) * sc;
                bf16* d = dstb + ((size_t)(((b * 8 + h) * 2 + c)) * SEQ + s) * 64 + 4 * j;
                *(u32x2*)d = pk4(o1); *(u32x2*)(d + 32) = pk4(o2);
            }
        }
    }
    {
        LAS bf16* Vs = (LAS bf16*)lds;
        for (int it = blockIdx.x; it < 64 * 64; it += gridDim.x) {
            const int bh = it >> 6, tile = it & 63, b = bh >> 3, h = bh & 7;
            { const int tk = tid >> 3, seg = tid & 7;
              const bf16* src = Z3 + (size_t)(b * SEQ + 64 * tile + tk) * Z3W + 2048 + h * 128 + 16 * seg;
              const u32x4 v0 = *(const u32x4*)src, v1 = *(const u32x4*)(src + 8);
              *(LAS u32x4*)(Vs + tk * 136 + 16 * seg) = v0; *(LAS u32x4*)(Vs + tk * 136 + 16 * seg + 8) = v1; }
            __syncthreads();
            { const int dv = tid >> 2, qr = tid & 3; unsigned w[8];
#pragma unroll
              for (int p = 0; p < 16; p += 2) {
                  const int k0 = 16 * qr + 4 * (p >> 3) + (p & 3) + 8 * ((p & 7) >> 2), k1 = k0 + 1;
                  w[p >> 1] = (unsigned)Vs[k0 * 136 + dv] | ((unsigned)Vs[k1 * 136 + dv] << 16);
              }
              bf16* dst = Vt + ((size_t)bh * 128 + dv) * SEQ + 64 * tile + 16 * qr;
              *(u32x4*)dst = (u32x4){w[0], w[1], w[2], w[3]}; *(u32x4*)(dst + 8) = (u32x4){w[4], w[5], w[6], w[7]}; }
            __syncthreads();
        }
    }
}

constexpr int AT_KB = 9216, AT_VB = 18432, AT_BUF = AT_KB + AT_VB;
__device__ __forceinline__ void attn_phase(const Args& a, LAS unsigned char* lds, const bf16* Qn, const bf16* Kn, const bf16* Vt, bf16* O, float* stash, int tid, int lane, int wave) {
    const int n32 = lane & 31, hi = lane >> 5;
    const float lam = *(const float*)(a.ws + WS_LAM);
    const float* subn = a.in[31];
    if (wave < 4) __builtin_amdgcn_s_setprio(2);
    for (int u = blockIdx.x; u < 1024; u += gridDim.x) {
        const int ub = u & 255, bh = (ub & 7) + 8 * (ub >> 5), quad = (ub >> 3) & 3, rnd = u >> 8;
        const int qb = rnd == 0 ? quad : (rnd == 1 ? 7 - quad : (rnd == 2 ? 8 + quad : 15 - quad));
        const int b = bh >> 3, h = bh & 7;
        const int NT = 4 * qb + 4, td = 4 * qb + (wave >> 1);
        const int qloc = 32 * (wave & 1) + n32;
        for (int c = 0; c < 2; ++c) {
            const bf16* Qp = Qn + ((size_t)(bh * 2 + c) * SEQ + 256 * qb + 32 * wave + n32) * 64 + 8 * hi;
            bf16x8 qf[4];
#pragma unroll
            for (int ds = 0; ds < 4; ++ds) qf[ds] = *(const bf16x8*)(Qp + 16 * ds);
            const bf16* Kp = Kn + (size_t)(bh * 2 + c) * SEQ * 64 + tid * 8;
            const bf16* Vp = Vt + (size_t)bh * 128 * SEQ + (size_t)(tid >> 3) * SEQ + 8 * (tid & 7);
            const int kofs = (tid >> 3) * 144 + (tid & 7) * 16;
            f32x16 o[4];
#pragma unroll
            for (int i = 0; i < 4; ++i)
#pragma unroll
                for (int r = 0; r < 16; ++r) o[i][r] = 0.f;
            float mrun = -INFINITY, lsum = 0.f;
            u32x4 kreg[2], vreg0[2], vreg1[2];
            kreg[0] = gload16_asm(Kp); vreg0[0] = gload16_asm(Vp); vreg1[0] = gload16_asm(Vp + (size_t)64 * SEQ);
            kreg[1] = gload16_asm(Kp + 4096); vreg0[1] = gload16_asm(Vp + 64); vreg1[1] = gload16_asm(Vp + (size_t)64 * SEQ + 64);
            asm volatile("" :: "v"(qf[0]), "v"(qf[1]), "v"(qf[2]), "v"(qf[3]));
            asm volatile("s_waitcnt vmcnt(3)" ::: "memory");
            *(LAS u32x4*)(lds + kofs) = kreg[0]; *(LAS u32x4*)(lds + AT_KB + kofs) = vreg0[0]; *(LAS u32x4*)(lds + AT_KB + 64 * 144 + kofs) = vreg1[0];
            lds_barrier();
            for (int tp = 0; tp < NT; tp += 2) {
#pragma unroll
              for (int hh = 0; hh < 2; ++hh) {
                const int t = tp + hh;
                if (t + 2 < NT) { kreg[hh] = gload16_asm(Kp + (size_t)(t + 2) * 4096); vreg0[hh] = gload16_asm(Vp + 64 * (t + 2)); vreg1[hh] = gload16_asm(Vp + (size_t)64 * SEQ + 64 * (t + 2)); }
                if (t <= td) {
                    const LAS unsigned char* kb = lds + (t & 1) * AT_BUF + n32 * 144 + hi * 16;
                    f32x16 p0, p1;
#pragma unroll
                    for (int r = 0; r < 16; ++r) { p0[r] = 0.f; p1[r] = 0.f; }
                    bf16x8 kf0[4], kf1[4];
#pragma unroll
                    for (int ds = 0; ds < 4; ++ds) { kf0[ds] = *(const LAS bf16x8*)(kb + ds * 32); kf1[ds] = *(const LAS bf16x8*)(kb + 32 * 144 + ds * 32); }
                    const LAS unsigned char* vb = lds + (t & 1) * AT_BUF + AT_KB + n32 * 144 + hi * 16;
                    bf16x8 vf[2][4];
#pragma unroll
                    for (int i = 0; i < 4; ++i) vf[0][i] = *(const LAS bf16x8*)(vb + i * 32 * 144);
                    __builtin_amdgcn_sched_barrier(0);
                    #pragma unroll
                    for (int ds = 0; ds < 4; ++ds) {
                        p0 = __builtin_amdgcn_mfma_f32_32x32x16_bf16(kf0[ds], qf[ds], p0, 0, 0, 0);
                        p1 = __builtin_amdgcn_mfma_f32_32x32x16_bf16(kf1[ds], qf[ds], p1, 0, 0, 0);
                    }
                                        __builtin_amdgcn_sched_barrier(0);
                    if (t == td) {
                        asm volatile("" ::: "memory");
#pragma unroll
                        for (int r = 0; r < 16; ++r) { const int key = (r & 3) + 8 * (r >> 2) + 4 * hi; if (key > qloc) p0[r] = -INFINITY; if (key + 32 > qloc) p1[r] = -INFINITY; }
                    }
                    asm volatile("s_nop 15\n\ts_nop 7" : "+v"(p0), "+v"(p1));
                    float mx, mxb;
                    mx = max3f(p0[0], p0[1], p1[0]); mxb = max3f(p0[2], p0[3], p1[1]); mx = max3f(mx, p1[2], p1[3]);
#pragma unroll
                    for (int r = 4; r < 16; r += 4) { mx = max3f(mx, p0[r], p0[r + 1]); mxb = max3f(mxb, p0[r + 2], p0[r + 3]); mx = max3f(mx, p1[r], p1[r + 1]); mxb = max3f(mxb, p1[r + 2], p1[r + 3]); }
                    mx = max3f(mx, mxb, mxb);
                    { auto rr = __builtin_amdgcn_permlane32_swap(__float_as_uint(mx), __float_as_uint(mx), false, false); mx = max3f(__uint_as_float(rr[0]), __uint_as_float(rr[1]), mrun); }
                    const float mnew = mx;
                    if (__builtin_amdgcn_ballot_w64(mnew > mrun + 8.0f)) {
                        const float alpha = __builtin_amdgcn_exp2f(mrun - mnew);
                        lsum *= alpha;
#pragma unroll
                        for (int i = 0; i < 4; ++i) o[i] = o[i] * alpha;
                        mrun = mnew;
                    }
                    {
                        const f32x2 mm2 = {mrun, mrun};
#pragma unroll
                        for (int r = 0; r < 16; r += 2) { const f32x2 a2 = (f32x2){p0[r], p0[r + 1]} - mm2, b2 = (f32x2){p1[r], p1[r + 1]} - mm2; p0[r] = a2.x; p0[r + 1] = a2.y; p1[r] = b2.x; p1[r + 1] = b2.y; }
                    }
#pragma unroll
                    for (int r = 0; r < 16; ++r) { p0[r] = __builtin_amdgcn_exp2f(p0[r]); p1[r] = __builtin_amdgcn_exp2f(p1[r]); }
                    {
                        const f32x16 ps = p0 + p1;
                        f32x2 s2 = (f32x2){ps[0], ps[1]} + (f32x2){ps[2], ps[3]};
#pragma unroll
                        for (int r = 4; r < 16; r += 2) s2 += (f32x2){ps[r], ps[r + 1]};
                        lsum += s2.x + s2.y;
                    }
                    bf16x8 pf[4];
#pragma unroll
                    for (int s4 = 0; s4 < 4; ++s4) {
                        u32x4 w;
                        if (s4 < 2) { w.x = pk2(p0[8 * s4 + 0], p0[8 * s4 + 1]); w.y = pk2(p0[8 * s4 + 2], p0[8 * s4 + 3]); w.z = pk2(p0[8 * s4 + 4], p0[8 * s4 + 5]); w.w = pk2(p0[8 * s4 + 6], p0[8 * s4 + 7]); }
                        else { const int q = s4 - 2; w.x = pk2(p1[8 * q + 0], p1[8 * q + 1]); w.y = pk2(p1[8 * q + 2], p1[8 * q + 3]); w.z = pk2(p1[8 * q + 4], p1[8 * q + 5]); w.w = pk2(p1[8 * q + 6], p1[8 * q + 7]); }
                        pf[s4] = __builtin_bit_cast(bf16x8, w);
                    }
#pragma unroll
                    for (int s4 = 0; s4 < 4; ++s4) {
                        if (s4 + 1 < 4) {
#pragma unroll
                            for (int i = 0; i < 4; ++i) vf[(s4 + 1) & 1][i] = *(const LAS bf16x8*)(vb + i * 32 * 144 + (s4 + 1) * 32);
                        }
                        __builtin_amdgcn_sched_barrier(0);
                        #pragma unroll
                        for (int i = 0; i < 4; ++i) o[i] = __builtin_amdgcn_mfma_f32_32x32x16_bf16(vf[s4 & 1][i], pf[s4], o[i], 0, 0, 0);
                                                __builtin_amdgcn_sched_barrier(0);
                    }
                }
                if (t + 1 < NT) { if (t + 2 < NT) asm volatile("s_waitcnt vmcnt(3)" ::: "memory"); else asm volatile("s_waitcnt vmcnt(0)" ::: "memory");
                    LAS unsigned char* d = lds + ((t + 1) & 1) * AT_BUF; *(LAS u32x4*)(d + kofs) = kreg[hh ^ 1]; *(LAS u32x4*)(d + AT_KB + kofs) = vreg0[hh ^ 1]; *(LAS u32x4*)(d + AT_KB + 64 * 144 + kofs) = vreg1[hh ^ 1]; }
                lds_barrier();
              }
            }
            const float inv = 1.0f / xhalf_sum(lsum);
            int oz; asm volatile("v_mov_b32 %0, 0" : "=v"(oz));
            float* st = stash + ((size_t)blockIdx.x * 8 + wave) * 4096 + lane + oz;
            if (c == 0) {
#pragma unroll
                for (int i = 0; i < 4; ++i)
#pragma unroll
                    for (int r = 0; r < 16; ++r) st[(i * 16 + r) * 64] = o[i][r] * inv;
            } else {
                float ss = 0.f;
#pragma unroll
                for (int i = 0; i < 4; ++i) {
                    float tv[16];
#pragma unroll
                    for (int r = 0; r < 16; ++r) tv[r] = st[(i * 16 + r) * 64];
                    asm volatile("" ::: "memory");
#pragma unroll
                    for (int r = 0; r < 16; ++r) { const float v = tv[r] - lam * (o[i][r] * inv); o[i][r] = v; ss += v * v; }
                }
                ss = xhalf_sum(ss);
                const float rs = rsqrtf(ss * (1.f / 128.f) + 1e-5f) * (1.0f - LAM_INIT);
                bf16* op = O + (size_t)(b * SEQ + 256 * qb + 32 * wave + n32 + oz) * DM + h * 128 + 4 * hi;
#pragma unroll
                for (int i = 0; i < 4; ++i)
#pragma unroll
                    for (int r4 = 0; r4 < 4; ++r4) {
                        const f32x4 sn = *(const f32x4*)(subn + 32 * i + 8 * r4 + 4 * hi);
                        const f32x4 v = (f32x4){o[i][4 * r4], o[i][4 * r4 + 1], o[i][4 * r4 + 2], o[i][4 * r4 + 3]} * rs * sn;
                        *(u32x2*)(op + 32 * i + 8 * r4) = pk4(v);
                    }
            }
        }
    }
    __builtin_amdgcn_s_setprio(0);
}

#define XB_TMO      128
#define XB_XCNT(j)  (256  + 64 * (j))
#define XB_XSUB(j)  (1280 + 64 * (j))
#define XB_XGEN(j)  (2304 + 64 * (j))
#define XB_TOP      3328
#define XB_TOPGEN   3392
#define XCD_BAR_WORDS 3456
#define XB_SPIN_CAP (1u << 18)

__device__ __forceinline__ unsigned xb_ld(unsigned* p)              { return __hip_atomic_load(p, __ATOMIC_RELAXED, __HIP_MEMORY_SCOPE_AGENT); }
__device__ __forceinline__ unsigned xb_add(unsigned* p, unsigned v) { return __hip_atomic_fetch_add(p, v, __ATOMIC_RELAXED, __HIP_MEMORY_SCOPE_AGENT); }
__device__ __forceinline__ unsigned xb_xcc_id() { return (unsigned)__builtin_amdgcn_s_getreg((3 << 11) | 20) & 0xFu; }
#define XB_SPIN(cond, bar) do { unsigned _sp = 0; while (cond) { __builtin_amdgcn_s_sleep(1); \
    if ((++_sp & 255u) == 0u) { if (xb_ld(&(bar)[XB_TMO])) break; if (_sp > XB_SPIN_CAP) { atomicAdd(&(bar)[XB_TMO], 1u); break; } } } } while (0)

struct XcdBarrier {
    unsigned* bar; unsigned x;
    volatile LAS unsigned* st;
};

__device__ __forceinline__ XcdBarrier xcd_barrier_post(unsigned* bar, volatile LAS unsigned* st) {
    XcdBarrier b; b.bar = bar; b.x = xb_xcc_id(); b.st = st;
    if (threadIdx.x == 0) (void)xb_add(&bar[XB_XCNT(b.x)], 1u);
    return b;
}
__device__ __forceinline__ void xcd_barrier_complete(unsigned* bar, unsigned x, unsigned& nloc, unsigned& nx) {
    const unsigned G = gridDim.x * gridDim.y * gridDim.z;
    unsigned sum, cnt, mine, sp = 0u;
    for (;;) {
        sum = 0u; cnt = 0u; mine = 0u;
#pragma unroll
        for (unsigned j = 0; j < 16; ++j) { const unsigned c = xb_ld(&bar[XB_XCNT(j)]); sum += c; cnt += (c > 0u) ? 1u : 0u; mine = (j == x) ? c : mine; }
        if (sum == G) break;
        __builtin_amdgcn_s_sleep(1);
        if ((++sp & 255u) == 0u) { if (xb_ld(&bar[XB_TMO])) break; if (sp > XB_SPIN_CAP) { atomicAdd(&bar[XB_TMO], 1u); break; } }
    }
    nloc = mine > 0u ? mine : 1u; nx = cnt > 0u ? cnt : 1u;
}

__device__ __forceinline__ void xcd_barrier(const XcdBarrier& b) {
    asm volatile("s_waitcnt vmcnt(0)" ::: "memory");
    __syncthreads();
    if (threadIdx.x == 0) {
        unsigned* bar = b.bar;
        __builtin_amdgcn_s_waitcnt(0);
        unsigned nloc = b.st[0], nx = b.st[1];
        if (nloc == 0u) { xcd_barrier_complete(bar, b.x, nloc, nx); b.st[0] = nloc; b.st[1] = nx; }
        const unsigned old = xb_add(&bar[XB_XSUB(b.x)], 1u);
        const unsigned gen = old / nloc;
        if (old + 1u == (gen + 1u) * nloc) {
            __builtin_amdgcn_fence(__ATOMIC_RELEASE, "agent");
            asm volatile("s_waitcnt vmcnt(0)" ::: "memory");
            const unsigned og = xb_add(&bar[XB_TOP], 1u);
            const unsigned tg = og / nx;
            if (og + 1u == (tg + 1u) * nx) xb_add(&bar[XB_TOPGEN], 1u);
            else XB_SPIN(xb_ld(&bar[XB_TOPGEN]) == tg, bar);
            __builtin_amdgcn_fence(__ATOMIC_ACQUIRE, "agent");
            xb_add(&bar[XB_XGEN(b.x)], 1u);
            asm volatile("s_waitcnt vmcnt(0)" ::: "memory");
        } else {
            XB_SPIN(xb_ld(&bar[XB_XGEN(b.x)]) == gen, bar);
            __builtin_amdgcn_fence(__ATOMIC_ACQUIRE, "agent");
            asm volatile("s_waitcnt vmcnt(0)" ::: "memory");
        }
    }
    __syncthreads();
}

#ifndef KMASK
#define KMASK 0xffff
#endif
#define KON(k) ((KMASK >> (k)) & 1)
constexpr int N_PHASES = 20;
__global__ void __launch_bounds__(NTHR, 2) mega_fwd(Args a) {
    extern __shared__ __attribute__((aligned(16))) unsigned char lds_raw[];
    LAS unsigned char* lds = (LAS unsigned char*)lds_raw;
    cg::grid_group grid = cg::this_grid();
    volatile LAS unsigned* bst = (volatile LAS unsigned*)(lds + 131072);
    if (threadIdx.x < 2) bst[threadIdx.x] = 0u;
    __syncthreads();
    const XcdBarrier xbar = xcd_barrier_post((unsigned*)(a.ws + WS_BAR), bst);
#ifndef KREP
#define KREP 0
#endif
    int rep = 0; (void)rep;
    for (int ph = a.ph_lo; ph < a.ph_hi; ++ph) {
        int oz; asm volatile("s_mov_b32 %0, 0" : "=s"(oz));
        const int tid = threadIdx.x + oz, lane = tid & 63, wave = __builtin_amdgcn_readfirstlane(tid >> 6);
        const int gw = blockIdx.x * NWAVES + wave, NGW = gridDim.x * NWAVES;
        unsigned char* ws = a.ws + oz;
        bf16* XN = (bf16*)(ws + WS_XN);
        bf16* BIG = (bf16*)(ws + WS_BIG);
        float* X = a.out + oz;
        int kind = 0, idx = 0;
        switch (ph) {
            case 0: kind = 0; break;
            case 1: kind = 1; idx = 0; break;
            case 2: kind = 2; idx = 0; break;
            case 3: kind = 4; idx = 0; break;
            case 4: kind = 5; break;
            case 5: kind = 6; break;
            case 6: kind = 7; break;
            case 7: kind = 8; break;
            case 8: kind = 9; break;
            case 9: kind = 10; idx = 0; break;
            case 10: kind = 1; idx = 1; break;
            case 11: kind = 2; idx = 1; break;
            case 12: kind = 1; idx = 2; break;
            case 13: kind = 2; idx = 2; break;
            case 14: kind = 4; idx = 1; break;
            case 15: kind = 11; break;
            case 16: kind = 12; break;
            case 17: kind = 10; idx = 1; break;
            case 18: kind = 1; idx = 3; break;
            default: kind = 2; idx = 3; break;
        }
        float* RSQ = (float*)(ws + WS_RSQ);
        if (kind == 0) { if (KON(0))
            prologue_phase(a, lds, tid, lane, wave);
        } else if (kind == 1) { if (KON(1)) {
            EpiSwiGLU E{BIG, ph == 1 ? (const float*)nullptr : (const float*)RSQ};
            run_gemm(lds, XN, (const bf16*)(ws + WS_WGU + idx * WGU_STRIDE), 2 * DFF, DM, E); }
        } else if (kind == 2 || kind == 10) { if (KON(2)) {
            const bool dn = kind == 2;
            const float* gn = ph == 2 ? a.in[5] : (ph == 9 ? a.in[1] + DM : (ph == 11 ? a.in[1] + 2 * DM : (ph == 13 ? a.in[5] + DM : (ph == 17 ? a.in[1] + 3 * DM : (const float*)nullptr))));
            EpiResid E{ph == 2 ? a.in[0] : (const float*)X, X, gn, XN, RSQ, dn ? 0.5f : 1.0f, 0.f};
            const bf16* A = dn ? (const bf16*)BIG : (idx == 0 ? (const bf16*)(ws + WS_R1) : (const bf16*)BIG);
            const bf16* Bt = dn ? (const bf16*)(ws + WS_WD + idx * WD_STRIDE) : (const bf16*)(ws + (idx == 0 ? WS_WEOUT : WS_WCOUT));
            run_gemm(lds, A, Bt, DM, dn ? DFF : DM, E); }
        } else if (kind == 4) { if (KON(4)) {
            EpiStore E{BIG, idx == 0 ? ZW : Z3W, (const float*)RSQ};
            run_gemm(lds, XN, (const bf16*)(ws + (idx == 0 ? WS_WAIN : WS_WCIN)), idx == 0 ? ZW : Z3W, DM, E); }
        } else if (kind == 5) { if (KON(5))
            e1_phase(BIG, a.in[7], (bf16*)(ws + WS_LRIN), tid);
        } else if (kind == 6) { if (KON(6)) {
            EpiLowRank E{(float*)(ws + WS_R1), (bf16*)(ws + WS_R2), (bf16*)(ws + WS_R4), a.in[8], a.in[10]};
            run_gemm(lds, (const bf16*)(ws + WS_LRIN), (const bf16*)(ws + WS_WBD), 1536, 256, E); }
        } else if (kind == 7) { if (KON(7))
            e2_phase(a, BIG, (bf16*)(ws + WS_R2), (float*)(ws + WS_R1), (bf16*)(ws + WS_R3), (float*)(ws + WS_BON), gw, NGW, lane);
        } else if (kind == 8) { if (KON(8))
            scan_phase(a, lds, BIG, (const float*)(ws + WS_R1), (const bf16*)(ws + WS_R2), (const bf16*)(ws + WS_R3), (float*)(ws + WS_XN), tid, lane, wave);
        } else if (kind == 9) { if (KON(9))
            e3_phase(a, lds, BIG, (const float*)(ws + WS_XN), (const float*)(ws + WS_BON), (const bf16*)(ws + WS_R4), (bf16*)(ws + WS_R1), tid, lane, wave);
        } else if (kind == 11) { if (KON(11))
            qkrope_phase(a, lds, BIG, (bf16*)(ws + WS_XN), (bf16*)(ws + WS_R1), (bf16*)(ws + WS_R2), tid, lane, wave);
        } else { if (KON(12))
            attn_phase(a, lds, (const bf16*)(ws + WS_XN), (const bf16*)(ws + WS_R1), (const bf16*)(ws + WS_R2), BIG, (float*)(ws + WS_BIG + 64 * MiB), tid, lane, wave);
        }
#if KREP
        if (!rep && ((KREP >> kind) & 1)) { rep = 1; --ph; } else rep = 0;
#endif
        if (ph + 1 < a.ph_hi) {
            if (ph == a.ph_lo) grid.sync(); else xcd_barrier(xbar);
        }
    }
}

#ifndef MK_PER_PHASE
#define MK_PER_PHASE 0
#endif
extern "C" void kernel_launch(void* const* d_in, const int* in_sizes, int n_in, void* d_out, int out_size, void* d_ws, size_t ws_size, hipStream_t stream) {
    static int grid = 0;
    if (grid == 0) {
        if (n_in != 33 || out_size != T * DM || ws_size < WS_END) { fprintf(stderr, "kernel_launch: unexpected shapes (n_in %d out %d ws %zu)\n", n_in, out_size, ws_size); grid = -1; return; }
        int dev = 0, cus = 0, per_cu = 0;
        hipGetDevice(&dev);
        hipDeviceGetAttribute(&cus, hipDeviceAttributeMultiprocessorCount, dev);
        if (hipFuncSetAttribute((const void*)mega_fwd, hipFuncAttributeMaxDynamicSharedMemorySize, LDS_BYTES) != hipSuccess) { fprintf(stderr, "kernel_launch: hipFuncSetAttribute failed\n"); grid = -1; return; }
        if (hipOccupancyMaxActiveBlocksPerMultiprocessor(&per_cu, (const void*)mega_fwd, NTHR, LDS_BYTES) != hipSuccess || per_cu < 1) { fprintf(stderr, "kernel_launch: occupancy query says %d\n", per_cu); per_cu = 1; }
        (void)hipGetLastError();
        grid = cus * per_cu;
    }
    if (grid < 0) return;
    if (hipMemsetAsync((char*)d_ws + WS_BAR, 0, 16384, stream) != hipSuccess) { fprintf(stderr, "kernel_launch: memset of the barrier words failed\n"); return; }
    Args a{};
    for (int i = 0; i < 33; ++i) a.in[i] = (const float*)d_in[i];
    a.out = (float*)d_out; a.ws = (unsigned char*)d_ws;
#if MK_PER_PHASE
    for (int ph = 0; ph < N_PHASES; ++ph) { a.ph_lo = ph; a.ph_hi = ph + 1; hipLaunchKernelGGL(mega_fwd, dim3(grid), dim3(NTHR), LDS_BYTES, stream, a); }
#else
    a.ph_lo = 0; a.ph_hi = N_PHASES;
    void* kargs[] = {&a};
    hipError_t e = hipLaunchCooperativeKernel((const void*)mega_fwd, dim3(grid), dim3(NTHR), kargs, LDS_BYTES, stream);
    if (e != hipSuccess) fprintf(stderr, "cooperative launch failed: %s (grid %d)\n", hipGetErrorString(e), grid);
#endif
}
```

```cpp
#include <hip/hip_runtime.h>
#include <hip/hip_cooperative_groups.h>
#include <cstdio>
#include <cstdint>
#include <cmath>
namespace cg = cooperative_groups;
namespace pg8 {
#define PG8_LAS __attribute__((address_space(3)))
typedef unsigned short bf16_t;
typedef short bf16x8 __attribute__((ext_vector_type(8)));
typedef float f32x4 __attribute__((ext_vector_type(4)));
typedef unsigned u32x4 __attribute__((ext_vector_type(4)));
constexpr int BM = 256, BK = 64, HALF = 128, HTB = HALF * BK * 2  , STAGE_BYTES = 8 * HTB, NXCD = 8, WGM = 8;

__host__ __device__ __forceinline__ int lds_byte(int r, int c) { const int st = (r >> 4) * 2 + (c >> 5), rr = r & 15, cc = c & 31, ob = rr * 64 + cc * 2; return st * 1024 + (ob ^ (((ob >> 9) & 1) << 5)); }
__host__ __device__ __forceinline__ void stage_rc(int b, int& R, int& C) { const int st = b / 1024, sb = b % 1024, swz = sb ^ (((sb >> 9) & 1) << 5); R = (st >> 1) * 16 + swz / 64; C = (st & 1) * 32 + (swz % 64) / 2; }
__host__ __device__ __forceinline__ int perm32(int rho) { const int n = rho >> 4, i = rho & 15; return 8 * (i >> 2) + 4 * n + (i & 3); }

struct Unit { int pm, pn; };
struct Gemm { const bf16_t* A; const bf16_t* Bt; int M, N, K; };

struct StaticOrder {
    int nM, nN, nwg, G, c;
    __host__ __device__ void init(int M, int N, int G_, int c_) { nM = M / BM; nN = N / BM; nwg = nM * nN; G = G_; c = c_; }
    __host__ __device__ bool next(int i, Unit& u) const {
        const long L = (long)i * G + c; if (L >= nwg) return false;
        int wgid = (int)L; { const int q = nwg / NXCD, r = nwg % NXCD, xcd = wgid % NXCD, off = wgid / NXCD; wgid = (xcd < r ? xcd * (q + 1) : r * (q + 1) + (xcd - r) * q) + off; }
        const int nig = WGM * nN, gid = wgid / nig, fm = gid * WGM, gsz = (nM - fm) < WGM ? (nM - fm) : WGM;
        u.pm = fm + ((wgid % nig) % gsz); u.pn = (wgid % nig) / gsz; return true;
    }
    __device__ __forceinline__ void a_ready(const Unit&) const {}
    __device__ __forceinline__ void done(const Unit&) const {}
};

__device__ __forceinline__ unsigned cvt_pk_bf16(float lo, float hi) { unsigned r; asm volatile("v_cvt_pk_bf16_f32 %0, %1, %2" : "=v"(r) : "v"(lo), "v"(hi)); return r; }
typedef float f32x2 __attribute__((ext_vector_type(2)));
__device__ __forceinline__ f32x2 gelu_pk(f32x2 v) {
    const f32x2 av = __builtin_elementwise_abs(v), d = av * 0.2316418882f + 1.0f;
    f32x2 t; t.x = __builtin_amdgcn_rcpf(d.x); t.y = __builtin_amdgcn_rcpf(d.y);
    f32x2 q = t * 0.5307027145f + (-0.7265760135f); q = q * t + 0.7107068705f; q = q * t + (-0.142248368f); q = q * t + 0.127414796f; q = q * t;
    const f32x2 s = (v * v) * (-0.72134752044f);
    f32x2 e; e.x = __builtin_amdgcn_exp2f(s.x); e.y = __builtin_amdgcn_exp2f(s.y);
    const f32x2 m = v * (q * e), r = v - m;
    f32x2 o; o.x = v.x < 0.f ? m.x : r.x; o.y = v.y < 0.f ? m.y : r.y; return o;
}

template <int ACT  > struct EpiBf16 {
    static constexpr bool PERM = true, AFTER_DRAIN = false; static_assert(ACT == 0 || ACT == 1, "EpiBf16: ACT is 0 (none) or 1 (gelu_pk)");
    bf16_t* O; int ldc; const float* bias; int split_cols; size_t split_stride; float scale0;
    __device__ __forceinline__ void operator()(const f32x4 (&acc)[2][2][4][2], const Unit& u, int wr, int wc, int fr, int fq) const {
        const int row0 = u.pm * BM + wr * 64 + fr; int colt = u.pn * BM; bf16_t* base = O;
        float sc = 1.f; if (split_cols) { const int t = colt / split_cols; base += (size_t)t * split_stride; colt -= t * split_cols; if (t == 0) sc = scale0; }
        const int col0 = colt + wc * 32 + 8 * fq, bcol0 = u.pn * BM + wc * 32 + 8 * fq;
        f32x4 bv[2][2];
#pragma unroll
        for (int bj = 0; bj < 2; ++bj)
#pragma unroll
            for (int n = 0; n < 2; ++n) bv[bj][n] = bias ? *(const f32x4*)(bias + bcol0 + bj * HALF + 4 * n) : (f32x4){0.f, 0.f, 0.f, 0.f};
#pragma unroll
        for (int ai = 0; ai < 2; ++ai)
#pragma unroll
            for (int m = 0; m < 4; ++m) { bf16_t* rowp = base + (size_t)(row0 + ai * HALF + m * 16) * ldc + col0;
#pragma unroll
                for (int bj = 0; bj < 2; ++bj) { f32x4 v0 = acc[ai][bj][m][0] + bv[bj][0], v1 = acc[ai][bj][m][1] + bv[bj][1];
                    if (ACT == 1) { f32x2 a = gelu_pk((f32x2){v0[0], v0[1]}), b = gelu_pk((f32x2){v0[2], v0[3]}), c = gelu_pk((f32x2){v1[0], v1[1]}), d = gelu_pk((f32x2){v1[2], v1[3]});
                        v0 = (f32x4){a.x, a.y, b.x, b.y}; v1 = (f32x4){c.x, c.y, d.x, d.y}; }
                    v0 = v0 * sc; v1 = v1 * sc; u32x4 w; w.x = cvt_pk_bf16(v0[0], v0[1]); w.y = cvt_pk_bf16(v0[2], v0[3]); w.z = cvt_pk_bf16(v1[0], v1[1]); w.w = cvt_pk_bf16(v1[2], v1[3]);
                    *(u32x4*)(rowp + bj * HALF) = w; } }
    }
};
template <class Epi, class Sched, bool ALIGN_EPI = false, bool SP2 = false>
__device__ __forceinline__ void gemm_phase(PG8_LAS unsigned char* lds, const Gemm g, const Sched& S, const Epi& E) {
    int oz_; asm volatile("s_mov_b32 %0, 0" : "=s"(oz_));
    const int tid = threadIdx.x + oz_, wid = __builtin_amdgcn_readfirstlane(tid >> 6), lane = tid & 63, wr = wid >> 2, wc = wid & 3, fr = lane & 15, fq = lane >> 4;
    const int K = g.K, nt = K / BK;
    unsigned voffA[2], voffB[2];
#pragma unroll
    for (int i = 0; i < 2; ++i) { int R, C; stage_rc(tid * 16 + i * 8192, R, C); const int Rb = Epi::PERM ? ((R & ~31) + perm32(R & 31)) : R;
        voffA[i] = (unsigned)(R * K + C) * 2u; voffB[i] = (unsigned)(Rb * K + C) * 2u; }
    const size_t kstep = (size_t)(BK * 2);
    const size_t hstep = (size_t)HALF * K * 2;
    const size_t tstep = 2 * hstep;
    const unsigned ldsw = (unsigned)wid * 1024u;
    const int aoff = lds_byte(wr * 64 + fr, fq * 8), boff = lds_byte(wc * 32 + fr, fq * 8);
#define PG8_SA(b, h) (((b) * 2 + (h)) * HTB)
#define PG8_SB(b, h) ((4 + (b) * 2 + (h)) * HTB)
#define PG8_STAGE(bufoff, gbase, voff) do { _Pragma("unroll") for (int _i = 0; _i < 2; ++_i) \
        __builtin_amdgcn_global_load_lds((const unsigned*)((const char*)(gbase) + (voff)[_i]), (PG8_LAS unsigned*)(lds + (bufoff) + ldsw + _i * 8192), 16, 0, 0); } while (0)
#define PG8_LDA(dst, b, h) do { _Pragma("unroll") for (int m = 0; m < 4; ++m) _Pragma("unroll") for (int k = 0; k < 2; ++k) dst[m][k] = *(const PG8_LAS bf16x8*)(lds + PG8_SA(b, h) + aoff + m * 2048 + k * 1024); } while (0)
#define PG8_LDB(dst, b, h) do { _Pragma("unroll") for (int n = 0; n < 2; ++n) _Pragma("unroll") for (int k = 0; k < 2; ++k) dst[n][k] = *(const PG8_LAS bf16x8*)(lds + PG8_SB(b, h) + boff + n * 2048 + k * 1024); } while (0)
#define PG8_MMA(ai, bj, At, Bt) do { __builtin_amdgcn_s_setprio(1); _Pragma("unroll") for (int m = 0; m < 4; ++m) _Pragma("unroll") for (int n = 0; n < 2; ++n) _Pragma("unroll") for (int k = 0; k < 2; ++k) \
        acc[ai][bj][m][n] = __builtin_amdgcn_mfma_f32_16x16x32_bf16(Bt[n][k], At[m][k], acc[ai][bj][m][n], 0, 0, 0); __builtin_amdgcn_s_setprio(0); } while (0)
#define PG8_WAIT_V(n) asm volatile("s_waitcnt vmcnt(" #n ")" ::: "memory")
#define PG8_WAIT_L(n) asm volatile("s_waitcnt lgkmcnt(" #n ")" ::: "memory")
#define PG8_BAR __builtin_amdgcn_s_barrier()
#define PG8_SCHED __builtin_amdgcn_sched_barrier(0)
    Unit cur, nxt; int ui = 0;
    if (!S.next(0, cur)) return;
    f32x4 acc[2][2][4][2];
#pragma unroll
    for (int a = 0; a < 2; ++a)
#pragma unroll
        for (int b = 0; b < 2; ++b)
#pragma unroll
            for (int m = 0; m < 4; ++m)
#pragma unroll
                for (int n = 0; n < 2; ++n) acc[a][b][m][n] = (f32x4){0.f, 0.f, 0.f, 0.f};
    bf16x8 At[4][2], B0[2][2], B1[2][2];
    const char* cA = (const char*)g.A + (size_t)cur.pm * tstep; const char* cB = (const char*)g.Bt + (size_t)cur.pn * tstep;
    S.a_ready(cur);
    if constexpr (SP2) {
        PG8_STAGE(PG8_SB(0, 0), cB, voffB); PG8_STAGE(PG8_SB(0, 1), cB + hstep, voffB); PG8_STAGE(PG8_SA(0, 0), cA, voffA); PG8_STAGE(PG8_SA(0, 1), cA + hstep, voffA);
        if (wr == 1) PG8_BAR;
        PG8_WAIT_V(2); PG8_BAR;
        PG8_STAGE(PG8_SB(1, 0), cB + kstep, voffB); PG8_STAGE(PG8_SA(1, 0), cA + kstep, voffA); PG8_STAGE(PG8_SB(1, 1), cB + hstep + kstep, voffB);
        PG8_WAIT_V(6); PG8_BAR;
    } else {
        PG8_STAGE(PG8_SB(0, 0), cB, voffB); PG8_STAGE(PG8_SA(0, 0), cA, voffA); PG8_STAGE(PG8_SB(0, 1), cB + hstep, voffB); PG8_STAGE(PG8_SA(0, 1), cA + hstep, voffA);
        if (wr == 1) PG8_BAR;
        PG8_WAIT_V(4); PG8_BAR;
        PG8_STAGE(PG8_SB(1, 0), cB + kstep, voffB); PG8_STAGE(PG8_SA(1, 0), cA + kstep, voffA); PG8_STAGE(PG8_SB(1, 1), cB + hstep + kstep, voffB);
        PG8_WAIT_V(6); PG8_BAR;
    }
    for (;;) {
        const bool has_next = S.next(ui + 1, nxt);
        const char* nA = has_next ? (const char*)g.A + (size_t)nxt.pm * tstep : cA; const char* nB = has_next ? (const char*)g.Bt + (size_t)nxt.pn * tstep : cB;
        for (int t = 0; t < nt; t += 2) {
            const bool last = (t == nt - 2);
            const char* a1 = cA + (size_t)(t + 1) * kstep;
            const char* a2 = last ? nA : cA + (size_t)(t + 2) * kstep; const char* b2 = last ? nB : cB + (size_t)(t + 2) * kstep;
            const char* a3 = a2 + kstep; const char* b3 = b2 + kstep;
            if (last && has_next) S.a_ready(nxt);
            if constexpr (SP2) {
            PG8_LDB(B0, 0, 0); PG8_LDB(B1, 0, 1); PG8_SCHED; PG8_LDA(At, 0, 0); PG8_STAGE(PG8_SA(1, 1), a1 + hstep, voffA);
            PG8_WAIT_V(8); PG8_WAIT_L(0); PG8_BAR; PG8_MMA(0, 0, At, B0); PG8_MMA(0, 1, At, B1); PG8_BAR; PG8_SCHED;
            PG8_LDA(At, 0, 1); PG8_STAGE(PG8_SB(0, 0), b2, voffB); PG8_STAGE(PG8_SB(0, 1), b2 + hstep, voffB); PG8_STAGE(PG8_SA(0, 0), a2, voffA);
            PG8_WAIT_V(8); PG8_WAIT_L(0); PG8_BAR; PG8_MMA(1, 0, At, B0); PG8_MMA(1, 1, At, B1); PG8_BAR; PG8_SCHED;
            PG8_LDB(B0, 1, 0); PG8_LDB(B1, 1, 1); PG8_SCHED; PG8_LDA(At, 1, 0); PG8_STAGE(PG8_SA(0, 1), a2 + hstep, voffA);
            PG8_WAIT_V(8); PG8_WAIT_L(0); PG8_BAR; PG8_MMA(0, 0, At, B0); PG8_MMA(0, 1, At, B1); PG8_BAR; PG8_SCHED;
            PG8_LDA(At, 1, 1); PG8_STAGE(PG8_SB(1, 0), b3, voffB); PG8_STAGE(PG8_SB(1, 1), b3 + hstep, voffB); PG8_STAGE(PG8_SA(1, 0), a3, voffA);
            PG8_WAIT_V(8); PG8_WAIT_L(0); PG8_BAR; PG8_MMA(1, 0, At, B0); PG8_MMA(1, 1, At, B1); PG8_BAR; PG8_SCHED;
            } else {
            PG8_LDB(B0, 0, 0); PG8_SCHED; PG8_LDA(At, 0, 0); PG8_STAGE(PG8_SA(1, 1), a1 + hstep, voffA);
            PG8_WAIT_L(8); PG8_BAR; PG8_WAIT_L(0); PG8_MMA(0, 0, At, B0); PG8_BAR; PG8_SCHED;
            PG8_LDB(B1, 0, 1); PG8_STAGE(PG8_SB(0, 0), b2, voffB);
            PG8_BAR; PG8_WAIT_L(0); PG8_MMA(0, 1, At, B1); PG8_BAR;
            PG8_LDA(At, 0, 1); PG8_STAGE(PG8_SA(0, 0), a2, voffA);
            PG8_BAR; PG8_WAIT_L(0); PG8_MMA(1, 0, At, B0); PG8_BAR; PG8_SCHED;
            PG8_STAGE(PG8_SB(0, 1), b2 + hstep, voffB);
            PG8_WAIT_V(6); PG8_BAR; PG8_MMA(1, 1, At, B1); PG8_BAR;
            PG8_LDB(B0, 1, 0); PG8_SCHED; PG8_LDA(At, 1, 0); PG8_STAGE(PG8_SA(0, 1), a2 + hstep, voffA);
            PG8_WAIT_L(8); PG8_BAR; PG8_WAIT_L(0); PG8_MMA(0, 0, At, B0); PG8_BAR; PG8_SCHED;
            PG8_LDB(B1, 1, 1); PG8_STAGE(PG8_SB(1, 0), b3, voffB);
            PG8_BAR; PG8_WAIT_L(0); PG8_MMA(0, 1, At, B1); PG8_BAR;
            PG8_LDA(At, 1, 1); PG8_STAGE(PG8_SA(1, 0), a3, voffA);
            PG8_BAR; PG8_WAIT_L(0); PG8_MMA(1, 0, At, B0); PG8_BAR; PG8_SCHED;
            PG8_STAGE(PG8_SB(1, 1), b3 + hstep, voffB);
            PG8_WAIT_V(6); PG8_BAR; PG8_MMA(1, 1, At, B1); PG8_BAR;
            }
        }
        if constexpr (ALIGN_EPI) { if (wr == 0) PG8_BAR; }
        if constexpr (!Epi::AFTER_DRAIN) { E(acc, cur, wr, wc, fr, fq); S.done(cur); }
        if (!has_next) break;
#pragma unroll
        for (int a = 0; a < 2; ++a)
#pragma unroll
            for (int b = 0; b < 2; ++b)
#pragma unroll
                for (int m = 0; m < 4; ++m)
#pragma unroll
                    for (int n = 0; n < 2; ++n) acc[a][b][m][n] = (f32x4){0.f, 0.f, 0.f, 0.f};
        cur = nxt; cA = nA; cB = nB; ++ui;
        if constexpr (ALIGN_EPI) { if (wr == 1) PG8_BAR; }
    }
    PG8_WAIT_V(0);
    if constexpr (!ALIGN_EPI) { if (wr == 0) PG8_BAR; }
    PG8_BAR;
    if constexpr (Epi::AFTER_DRAIN) { E.fused(acc, cur, wr, wc, fr, fq, lds, wid, lane); S.done(cur); }
#undef PG8_SA
#undef PG8_SB
#undef PG8_STAGE
#undef PG8_LDA
#undef PG8_LDB
#undef PG8_MMA
#undef PG8_WAIT_V
#undef PG8_WAIT_L
#undef PG8_BAR
#undef PG8_SCHED
}
}

#define LAS __attribute__((address_space(3)))
typedef unsigned short bf16;
typedef float f32x4 __attribute__((ext_vector_type(4)));
typedef float f32x2 __attribute__((ext_vector_type(2)));
typedef float f32x16 __attribute__((ext_vector_type(16)));
typedef short bf16x8 __attribute__((ext_vector_type(8)));
typedef unsigned u32x4 __attribute__((ext_vector_type(4)));
typedef unsigned u32x2 __attribute__((ext_vector_type(2)));
typedef __bf16 bf16x2_t __attribute__((ext_vector_type(2)));

constexpr int NWAVES = 8, NTHR = 512;
constexpr int BATCH = 8, SEQ = 4096, DM = 1024, T = BATCH * SEQ, DFF = 2816;
constexpr int ZW = 2816;
constexpr int Z3W = 3072;
constexpr int LDS_BYTES = 147456;
constexpr float LAM_INIT = 0.35550906759096934f;
constexpr float QSCALE = 0.125f * 1.4426950408889634f;

constexpr size_t MiB = 1u << 20;
constexpr size_t WS_WGU = 0;
constexpr size_t WGU_STRIDE = (size_t)5632 * 1024 * 2;
constexpr size_t WS_WD = 44 * MiB;
constexpr size_t WD_STRIDE = (size_t)1024 * 2816 * 2;
constexpr size_t WS_WAIN = 66 * MiB;
constexpr size_t WS_WEOUT = 72 * MiB;
constexpr size_t WS_WCIN = 74 * MiB;
constexpr size_t WS_WCOUT = 80 * MiB;
constexpr size_t WS_WBD = 82 * MiB;
constexpr size_t WS_ROPE = 83 * MiB;
constexpr size_t WS_BON = 84 * MiB;
constexpr size_t WS_LAM = 85 * MiB;
constexpr size_t WS_BAR = 85 * MiB + 65536;
constexpr size_t WS_RSQ = 86 * MiB;
constexpr size_t WS_XN = 88 * MiB;
constexpr size_t WS_BIG = 152 * MiB;
constexpr size_t WS_LRIN = 328 * MiB;
constexpr size_t WS_R1 = 344 * MiB;
constexpr size_t WS_R2 = 408 * MiB;
constexpr size_t WS_R3 = 440 * MiB;
constexpr size_t WS_R4 = 472 * MiB;
constexpr size_t WS_END = 504 * MiB;

__device__ const float ROPE_INV[32] = {
    1.000000000e+00f, 7.498942018e-01f, 5.623413324e-01f, 4.216965139e-01f, 3.162277639e-01f, 2.371373922e-01f, 1.778279394e-01f, 1.333521456e-01f,
    1.000000015e-01f, 7.498941571e-02f, 5.623412877e-02f, 4.216964915e-02f, 3.162277862e-02f, 2.371373586e-02f, 1.778279431e-02f, 1.333521493e-02f,
    9.999999776e-03f, 7.498942316e-03f, 5.623413250e-03f, 4.216964822e-03f, 3.162277862e-03f, 2.371373819e-03f, 1.778279431e-03f, 1.333521446e-03f,
    1.000000047e-03f, 7.498941850e-04f, 5.623413017e-04f, 4.216965463e-04f, 3.162277862e-04f, 2.371373848e-04f, 1.778279402e-04f, 1.333521504e-04f};

__device__ __forceinline__ unsigned pk2(float lo, float hi) { f32x2 v = {lo, hi}; bf16x2_t b = __builtin_convertvector(v, bf16x2_t); return __builtin_bit_cast(unsigned, b); }
__device__ __forceinline__ float bflo(unsigned u) { return __uint_as_float(u << 16); }
__device__ __forceinline__ float bfhi(unsigned u) { return __uint_as_float(u & 0xffff0000u); }
__device__ __forceinline__ f32x4 bf4(u32x2 u) { return (f32x4){bflo(u.x), bfhi(u.x), bflo(u.y), bfhi(u.y)}; }
__device__ __forceinline__ u32x2 pk4(f32x4 v) { u32x2 r; r.x = pk2(v.x, v.y); r.y = pk2(v.z, v.w); return r; }
__device__ __forceinline__ float fexp(float x) { return __builtin_amdgcn_exp2f(x * 1.4426950408889634f); }
__device__ __forceinline__ float fsigmoid(float x) { return __builtin_amdgcn_rcpf(1.0f + fexp(-x)); }
__device__ __forceinline__ float ftanh(float x) { return 1.0f - 2.0f * __builtin_amdgcn_rcpf(fexp(2.0f * x) + 1.0f); }
template <int CTRL> __device__ __forceinline__ float dppf(float v) { return __int_as_float(__builtin_amdgcn_update_dpp(0, __float_as_int(v), CTRL, 0xf, 0xf, true)); }
__device__ __forceinline__ float red8(float v) { v += dppf<0xB1>(v); v += dppf<0x4E>(v); v += dppf<0x141>(v); return v; }
__device__ __forceinline__ float red16(float v) { v = red8(v); v += dppf<0x140>(v); return v; }
__device__ __forceinline__ float wave_sum(float v) {
    v = red16(v);
    const int i = __float_as_int(v);
    const float a0 = __int_as_float(__builtin_amdgcn_readlane(i, 0)), a1 = __int_as_float(__builtin_amdgcn_readlane(i, 16)), a2 = __int_as_float(__builtin_amdgcn_readlane(i, 32)), a3 = __int_as_float(__builtin_amdgcn_readlane(i, 48));
    return (a0 + a1) + (a2 + a3);
}
__device__ __forceinline__ float xhalf_sum(float v);
__device__ __forceinline__ float fq_sum(float v) {
    v += __int_as_float(__builtin_amdgcn_ds_swizzle(__float_as_int(v), 0x401F));
    auto rr = __builtin_amdgcn_permlane32_swap(__float_as_uint(v), __float_as_uint(v), false, false); return __uint_as_float(rr[0]) + __uint_as_float(rr[1]);
}
__device__ __forceinline__ float max3f(float a, float b, float c) { float r; asm("v_max3_f32 %0, %1, %2, %3" : "=v"(r) : "v"(a), "v"(b), "v"(c)); return r; }
__device__ __forceinline__ float xhalf_max(float v) { auto rr = __builtin_amdgcn_permlane32_swap(__float_as_uint(v), __float_as_uint(v), false, false); return fmaxf(__uint_as_float(rr[0]), __uint_as_float(rr[1])); }
__device__ __forceinline__ float xhalf_sum(float v) { auto rr = __builtin_amdgcn_permlane32_swap(__float_as_uint(v), __float_as_uint(v), false, false); return __uint_as_float(rr[0]) + __uint_as_float(rr[1]); }

__device__ __forceinline__ void lds_barrier() { asm volatile("s_waitcnt lgkmcnt(0)" ::: "memory"); __builtin_amdgcn_s_barrier(); asm volatile("" ::: "memory"); }
__device__ __forceinline__ u32x4 gload16_asm(const void* p) { u32x4 r; asm volatile("global_load_dwordx4 %0, %1, off" : "=v"(r) : "v"(p) : "memory"); return r; }
struct Args { const float* in[33]; float* out; unsigned char* ws; int ph_lo, ph_hi; };

__device__ __forceinline__ void row_rstd8(const float* rsq, int row0, int fq, float (&rs)[8]) {
    if (!rsq) {
#pragma unroll
        for (int i = 0; i < 8; ++i) rs[i] = 1.f;
        return;
    }
    f32x4 p[8];
#pragma unroll
    for (int i = 0; i < 8; ++i) p[i] = *(const f32x4*)(rsq + (size_t)(row0 + (i >> 2) * 128 + (i & 3) * 16) * 16 + 4 * fq);
    asm volatile("" ::: "memory");
#pragma unroll
    for (int i = 0; i < 8; ++i) rs[i] = rsqrtf(fq_sum((p[i].x + p[i].y) + (p[i].z + p[i].w)) * (1.f / DM) + 1e-6f);
}
struct EpiSwiGLU {
    static constexpr bool PERM = true, AFTER_DRAIN = false;
    bf16* O;
    const float* rsq;
    __device__ __forceinline__ void operator()(const pg8::f32x4 (&acc)[2][2][4][2], const pg8::Unit& u, int wr, int wc, int fr, int fq) const {
        int oz; asm volatile("v_mov_b32 %0, 0" : "=v"(oz));
        const int row0 = u.pm * 256 + wr * 64 + fr + oz, col0 = u.pn * 128 + wc * 32 + 8 * fq;
        float rs8[8]; row_rstd8(rsq, row0, fq, rs8);
#pragma unroll
        for (int ai = 0; ai < 2; ++ai)
#pragma unroll
            for (int m = 0; m < 4; ++m) {
                bf16* p = O + (size_t)(row0 + ai * 128 + m * 16) * DFF + col0;
                const float r = rs8[ai * 4 + m];
                const f32x2 rr2 = {r * r, r * r}, nl2 = {-1.4426950408889634f * r, -1.4426950408889634f * r};
                unsigned w[4];
#pragma unroll
                for (int n = 0; n < 2; ++n)
#pragma unroll
                    for (int e = 0; e < 4; e += 2) {
                        const f32x2 ag = {acc[ai][0][m][n][e], acc[ai][0][m][n][e + 1]}, au = {acc[ai][1][m][n][e], acc[ai][1][m][n][e + 1]};
                        const f32x2 x = ag * nl2;
                        f32x2 d = {__builtin_amdgcn_exp2f(x.x), __builtin_amdgcn_exp2f(x.y)};
                        d = d + 1.0f;
                        const f32x2 rc = {__builtin_amdgcn_rcpf(d.x), __builtin_amdgcn_rcpf(d.y)};
                        const f32x2 hh = (ag * au) * (rc * rr2);
                        w[2 * n + (e >> 1)] = pk2(hh.x, hh.y);
                    }
                __builtin_nontemporal_store((u32x4){w[0], w[1], w[2], w[3]}, (u32x4*)p);
            }
    }
};
struct EpiResid {
    static constexpr bool PERM = false, AFTER_DRAIN = false;
    const float* base; float* out; const float* gn; bf16* XN; float* rsq; float scale, pad_;
    __device__ __forceinline__ void operator()(const pg8::f32x4 (&acc)[2][2][4][2], const pg8::Unit& u, int wr, int wc, int fr, int fq) const {
        int oz; asm volatile("v_mov_b32 %0, 0" : "=v"(oz));
        const int row0 = u.pm * 256 + wr * 64 + fr + oz, col0 = u.pn * 256 + wc * 32 + 4 * fq;
        const float* gp = gn ? gn : base;
        f32x4 g4[2][2];
#pragma unroll
        for (int bj = 0; bj < 2; ++bj)
#pragma unroll
            for (int n = 0; n < 2; ++n) g4[bj][n] = *(const f32x4*)(gp + col0 + bj * 128 + n * 16);
#pragma unroll
        for (int ai = 0; ai < 2; ++ai) {
            f32x4 bv[4][2][2];
#pragma unroll
            for (int m = 0; m < 4; ++m)
#pragma unroll
                for (int bj = 0; bj < 2; ++bj)
#pragma unroll
                    for (int n = 0; n < 2; ++n) bv[m][bj][n] = *(const f32x4*)(base + (size_t)(row0 + ai * 128 + m * 16) * DM + col0 + bj * 128 + n * 16);
            asm volatile("" ::: "memory");
#pragma unroll
            for (int m = 0; m < 4; ++m) {
                const int row = row0 + ai * 128 + m * 16;
                const size_t ro = (size_t)row * DM + col0;
                float ss = 0.f;
#pragma unroll
                for (int bj = 0; bj < 2; ++bj)
#pragma unroll
                    for (int n = 0; n < 2; ++n) {
                        const size_t off = ro + bj * 128 + n * 16;
                        f32x4 a; a.x = acc[ai][bj][m][n][0]; a.y = acc[ai][bj][m][n][1]; a.z = acc[ai][bj][m][n][2]; a.w = acc[ai][bj][m][n][3];
                        const f32x4 v = bv[m][bj][n] + a * scale;
                        *(f32x4*)(out + off) = v;
                        if (gn) { *(u32x2*)(XN + off) = pk4(v * g4[bj][n]); ss += (v.x * v.x + v.y * v.y) + (v.z * v.z + v.w * v.w); }
                    }
                if (gn) { ss = fq_sum(ss); if (fq == 0) rsq[(size_t)row * 16 + u.pn * 4 + wc] = ss; }
            }
        }
    }
};
struct EpiStore {
    static constexpr bool PERM = true, AFTER_DRAIN = false;
    bf16* O; int ldc; const float* rsq;
    __device__ __forceinline__ void operator()(const pg8::f32x4 (&acc)[2][2][4][2], const pg8::Unit& u, int wr, int wc, int fr, int fq) const {
        int oz; asm volatile("v_mov_b32 %0, 0" : "=v"(oz));
        const int row0 = u.pm * 256 + wr * 64 + fr + oz, col0 = u.pn * 256 + wc * 32 + 8 * fq;
        float rs8[8]; row_rstd8(rsq, row0, fq, rs8);
#pragma unroll
        for (int ai = 0; ai < 2; ++ai)
#pragma unroll
            for (int m = 0; m < 4; ++m) {
                bf16* p = O + (size_t)(row0 + ai * 128 + m * 16) * ldc + col0;
                const float r = rs8[ai * 4 + m];
#pragma unroll
                for (int bj = 0; bj < 2; ++bj) {
                    u32x4 w; w.x = pk2(acc[ai][bj][m][0][0] * r, acc[ai][bj][m][0][1] * r); w.y = pk2(acc[ai][bj][m][0][2] * r, acc[ai][bj][m][0][3] * r);
                    w.z = pk2(acc[ai][bj][m][1][0] * r, acc[ai][bj][m][1][1] * r); w.w = pk2(acc[ai][bj][m][1][2] * r, acc[ai][bj][m][1][3] * r);
                    __builtin_nontemporal_store(w, (u32x4*)(p + bj * 128));
                }
            }
    }
};
__device__ __forceinline__ float decay_f(float x) {
    const float y = -x, sp = fmaxf(y, 0.f) + __builtin_amdgcn_logf(1.0f + fexp(-fabsf(y))) * 0.6931471805599453f;
    return fexp(-fexp(-sp - 0.5f));
}

struct EpiLowRank {
    static constexpr bool PERM = true, AFTER_DRAIN = false;
    float* W; bf16* Aa; bf16* G; const float* w0; const float* a0;
    __device__ __forceinline__ void operator()(const pg8::f32x4 (&acc)[2][2][4][2], const pg8::Unit& u, int wr, int wc, int fr, int fq) const {
        const int region = u.pn >> 1;
        int oz; asm volatile("v_mov_b32 %0, 0" : "=v"(oz));
        const int row0 = u.pm * 256 + wr * 64 + fr + oz, col0 = (u.pn & 1) * 256 + wc * 32 + 8 * fq;
        bf16* OB = region == 1 ? Aa : G;
        const float* bp = region == 0 ? w0 : a0;
#pragma unroll
        for (int bj = 0; bj < 2; ++bj) {
            f32x4 b0 = {0.f, 0.f, 0.f, 0.f}, b1 = b0;
            if (region < 2) { b0 = *(const f32x4*)(bp + col0 + bj * 128); b1 = *(const f32x4*)(bp + col0 + bj * 128 + 4); }
#pragma unroll
            for (int ai = 0; ai < 2; ++ai)
#pragma unroll
                for (int m = 0; m < 4; ++m) {
                    const size_t off = (size_t)(row0 + ai * 128 + m * 16) * 512 + col0 + bj * 128;
                    f32x4 v0 = (f32x4){acc[ai][bj][m][0][0], acc[ai][bj][m][0][1], acc[ai][bj][m][0][2], acc[ai][bj][m][0][3]} + b0;
                    f32x4 v1 = (f32x4){acc[ai][bj][m][1][0], acc[ai][bj][m][1][1], acc[ai][bj][m][1][2], acc[ai][bj][m][1][3]} + b1;
                    if (region == 0) {
                        *(f32x4*)(W + off) = (f32x4){decay_f(v0.x), decay_f(v0.y), decay_f(v0.z), decay_f(v0.w)};
                        *(f32x4*)(W + off + 4) = (f32x4){decay_f(v1.x), decay_f(v1.y), decay_f(v1.z), decay_f(v1.w)};
                    } else {
                        if (region == 1) { v0 = (f32x4){fsigmoid(v0.x), fsigmoid(v0.y), fsigmoid(v0.z), fsigmoid(v0.w)}; v1 = (f32x4){fsigmoid(v1.x), fsigmoid(v1.y), fsigmoid(v1.z), fsigmoid(v1.w)}; }
                        u32x4 w; w.x = pk2(v0.x, v0.y); w.y = pk2(v0.z, v0.w); w.z = pk2(v1.x, v1.y); w.w = pk2(v1.z, v1.w);
                        *(u32x4*)(OB + off) = w;
                    }
                    asm volatile("" ::: "memory");
                }
        }
    }
};

template <class Epi> __device__ __forceinline__ void run_gemm(LAS unsigned char* lds, const bf16* A, const bf16* Bt, int N, int K, const Epi& E) {
    asm volatile("" : "+s"(N), "+s"(K));
    pg8::Gemm g{A, Bt, T, N, K}; pg8::StaticOrder S; S.init(T, N, (int)gridDim.x, (int)blockIdx.x);
    pg8::gemm_phase<Epi, pg8::StaticOrder, true, true>(lds, g, S, E);
}

__device__ __forceinline__ void transpose_item(const float* W, int K, int N, bf16* WT, int mode, LAS float* scr, int item, int lane) {
    const int nblk = N / 32, kb = item / nblk, nb = item % nblk, k0 = 64 * kb, n0 = 32 * nb;
    int drow0 = n0; if (mode) drow0 = 256 * (n0 >> 7) + (n0 & 127) + (mode == 2 ? 128 : 0);
    float tv[32];
#pragma unroll
    for (int i = 0; i < 32; ++i) tv[i] = W[(size_t)(k0 + 2 * i + (lane >> 5)) * N + n0 + (lane & 31)];
#pragma unroll
    for (int i = 0; i < 32; ++i) scr[(2 * i + (lane >> 5)) * 33 + (lane & 31)] = tv[i];
    asm volatile("s_waitcnt lgkmcnt(0)" ::: "memory");
    const int c = lane & 7;
#pragma unroll
    for (int j = 0; j < 4; ++j) { const int n = (lane >> 3) + 8 * j; const LAS float* s = scr + (8 * c) * 33 + n;
        u32x4 o; o.x = pk2(s[0 * 33], s[1 * 33]); o.y = pk2(s[2 * 33], s[3 * 33]); o.z = pk2(s[4 * 33], s[5 * 33]); o.w = pk2(s[6 * 33], s[7 * 33]);
        *(u32x4*)(WT + (size_t)(drow0 + n) * K + k0 + 8 * c) = o; }
    asm volatile("s_waitcnt lgkmcnt(0)" ::: "memory");
}

__device__ __forceinline__ void transpose_load(const float* W, int K, int N, int item, int lane, float (&tv)[32]) {
    const int nblk = N / 32, kb = item / nblk, nb = item % nblk, k0 = 64 * kb, n0 = 32 * nb;
#pragma unroll
    for (int i = 0; i < 32; ++i) tv[i] = W[(size_t)(k0 + 2 * i + (lane >> 5)) * N + n0 + (lane & 31)];
}
__device__ __forceinline__ void transpose_store(int K, int N, bf16* WT, int mode, LAS float* scr, int item, int lane, const float (&tv)[32]) {
    const int nblk = N / 32, kb = item / nblk, nb = item % nblk, k0 = 64 * kb, n0 = 32 * nb;
    int drow0 = n0; if (mode) drow0 = 256 * (n0 >> 7) + (n0 & 127) + (mode == 2 ? 128 : 0);
#pragma unroll
    for (int i = 0; i < 32; ++i) scr[(2 * i + (lane >> 5)) * 33 + (lane & 31)] = tv[i];
    asm volatile("s_waitcnt lgkmcnt(0)" ::: "memory");
    const int c = lane & 7;
#pragma unroll
    for (int j = 0; j < 4; ++j) { const int n = (lane >> 3) + 8 * j; const LAS float* sp = scr + (8 * c) * 33 + n;
        u32x4 o; o.x = pk2(sp[0 * 33], sp[1 * 33]); o.y = pk2(sp[2 * 33], sp[3 * 33]); o.z = pk2(sp[4 * 33], sp[5 * 33]); o.w = pk2(sp[6 * 33], sp[7 * 33]);
        *(u32x4*)(WT + (size_t)(drow0 + n) * K + k0 + 8 * c) = o; }
    asm volatile("s_waitcnt lgkmcnt(0)" ::: "memory");
}
constexpr int DI_GU = 16 * 88, DI_D = 44 * 32, DI_SQ = 16 * 32, DI_CIN = 16 * 96;
constexpr int DEFER_ITEMS = 6 * DI_GU + 3 * DI_D + DI_SQ + DI_CIN + DI_SQ;
struct DeferItem { const float* W; bf16* WT; int K, N, mode, item; };
__device__ __forceinline__ DeferItem defer_decode(const Args& a, int it) {
    DeferItem d; unsigned char* ws = a.ws; int r = it;
    if (r < 6 * DI_GU) { const int f = 1 + r / (2 * DI_GU), which = (r / DI_GU) & 1;
        d.W = (which ? a.in[3] : a.in[2]) + (size_t)f * DM * DFF; d.WT = (bf16*)(ws + WS_WGU + f * WGU_STRIDE); d.K = DM; d.N = DFF; d.mode = 1 + which; d.item = r % DI_GU; return d; }
    r -= 6 * DI_GU;
    if (r < 3 * DI_D) { const int f = 1 + r / DI_D; d.W = a.in[4] + (size_t)f * DFF * DM; d.WT = (bf16*)(ws + WS_WD + f * WD_STRIDE); d.K = DFF; d.N = DM; d.mode = 0; d.item = r % DI_D; return d; }
    r -= 3 * DI_D;
    if (r < DI_SQ) { d.W = a.in[23]; d.WT = (bf16*)(ws + WS_WEOUT); d.K = DM; d.N = DM; d.mode = 0; d.item = r; return d; } r -= DI_SQ;
    if (r < DI_CIN) { d.W = a.in[24]; d.WT = (bf16*)(ws + WS_WCIN); d.K = DM; d.N = Z3W; d.mode = 0; d.item = r; return d; } r -= DI_CIN;
    d.W = a.in[32]; d.WT = (bf16*)(ws + WS_WCOUT); d.K = DM; d.N = DM; d.mode = 0; d.item = r; return d;
}

__device__ __forceinline__ void rmsnorm_phase(const float* X, const float* g, bf16* XN, int gw, int NGW, int lane) {
    f32x4 gv[4];
#pragma unroll
    for (int j = 0; j < 4; ++j) gv[j] = *(const f32x4*)(g + 4 * lane + 256 * j);
#pragma unroll 4
    for (int m = gw; m < T; m += NGW) {
        const f32x4* xr = (const f32x4*)(X + (size_t)m * DM) + lane;
        f32x4 v[4]; float s = 0.f;
#pragma unroll
        for (int j = 0; j < 4; ++j) { v[j] = xr[64 * j]; s += (v[j].x * v[j].x + v[j].y * v[j].y) + (v[j].z * v[j].z + v[j].w * v[j].w); }
        const float rstd = rsqrtf(wave_sum(s) * (1.f / DM) + 1e-6f);
        u32x2* o8 = (u32x2*)(XN + (size_t)m * DM) + lane;
#pragma unroll
        for (int j = 0; j < 4; ++j) o8[64 * j] = pk4(v[j] * rstd * gv[j]);
    }
}

__device__ __forceinline__ void prologue_phase(const Args& a, LAS unsigned char* lds, int tid, int lane, int wave) {
    unsigned char* ws = a.ws;
    LAS float* scr = (LAS float*)(lds + wave * 16384);
    const int gw = blockIdx.x * NWAVES + wave, NGW = gridDim.x * NWAVES;
    constexpr int I_GU = 16 * 88, I_D = 44 * 32, I_AIN = 16 * 88;
    constexpr int NITEMS = 2 * I_GU + I_D + I_AIN;
    for (int it = gw; it < NITEMS; it += NGW) {
        int r = it;
        if (r < 2 * I_GU) { const int which = r / I_GU, i = r % I_GU; transpose_item(which ? a.in[3] : a.in[2], DM, DFF, (bf16*)(ws + WS_WGU), 1 + which, scr, i, lane); continue; }
        r -= 2 * I_GU;
        if (r < I_D) { transpose_item(a.in[4], DFF, DM, (bf16*)(ws + WS_WD), 0, scr, r, lane); continue; }
        r -= I_D;
        transpose_item(a.in[6], DM, ZW, (bf16*)(ws + WS_WAIN), 0, scr, r, lane);
    }
    {
        bf16* BD = (bf16*)(ws + WS_WBD);
        const int gt = blockIdx.x * NTHR + tid, NGT = gridDim.x * NTHR;
        for (int i = gt; i < 1536 * 256; i += NGT) {
            const int n = i >> 8, k = i & 255; float v = 0.f;
            if (n < 512) { if (k < 64) v = a.in[9][k * 512 + n]; }
            else if (n < 1024) { if (k >= 64 && k < 128) v = a.in[11][(k - 64) * 512 + (n - 512)]; }
            else { if (k >= 128) v = a.in[12][(k - 128) * 512 + (n - 1024)]; }
            BD[i] = (bf16)(pk2(v, 0.f) & 0xffffu);
        }
        float* COS = (float*)(ws + WS_ROPE); float* SIN = COS + SEQ * 32;
        for (int i = gt; i < SEQ * 32; i += NGT) {
            const int s = i >> 5, j = i & 31;
            const float ang = (float)s * ROPE_INV[j];
            double rev = (double)ang * 0.15915494309189535; rev -= floor(rev);
            COS[i] = __builtin_amdgcn_cosf((float)rev); SIN[i] = __builtin_amdgcn_sinf((float)rev);
        }
        if (blockIdx.x == 0 && wave == 0) {
            const float s1 = wave_sum(a.in[27][lane] * a.in[28][lane]), s2 = wave_sum(a.in[29][lane] * a.in[30][lane]);
            if (lane == 0) *(float*)(ws + WS_LAM) = expf(s1) - expf(s2) + LAM_INIT;
        }
    }
    rmsnorm_phase(a.in[0], a.in[1], (bf16*)(ws + WS_XN), gw, NGW, lane);
}

__device__ __forceinline__ void e1_phase(const bf16* Z, const float* mu, bf16* LR, int tid) {
    const int seg = tid & 31, col = 1536 + 8 * seg;
    float muv[8];
#pragma unroll
    for (int e = 0; e < 8; ++e) muv[e] = mu[col + e];
#pragma unroll 2
    for (int it = blockIdx.x; it < T / 16; it += gridDim.x) {
        const int m = it * 16 + (tid >> 5), s = m & (SEQ - 1);
        const u32x4 zc = *(const u32x4*)(Z + (size_t)m * ZW + col);
        u32x4 zp = {0u, 0u, 0u, 0u}; if (s) zp = *(const u32x4*)(Z + (size_t)(m - 1) * ZW + col);
        float v[8];
#pragma unroll
        for (int e = 0; e < 4; ++e) { const float c0 = bflo(zc[e]), c1 = bfhi(zc[e]), p0 = bflo(zp[e]), p1 = bfhi(zp[e]);
            v[2 * e] = c0 + (p0 - c0) * muv[2 * e]; v[2 * e + 1] = c1 + (p1 - c1) * muv[2 * e + 1]; }
        if (seg < 8) {
#pragma unroll
            for (int e = 0; e < 8; ++e) v[e] = ftanh(v[e]);
        } else if (seg >= 16) {
#pragma unroll
            for (int e = 0; e < 8; ++e) v[e] = fsigmoid(v[e]);
        }
        u32x4 w; w.x = pk2(v[0], v[1]); w.y = pk2(v[2], v[3]); w.z = pk2(v[4], v[5]); w.w = pk2(v[6], v[7]);
        *(u32x4*)(LR + (size_t)m * 256 + 8 * seg) = w;
    }
}
__device__ __forceinline__ void e2_phase(const Args& a, const bf16* Z, bf16* Aa, float* W, bf16* KK, float* BON, int gw, int NGW, int lane) {
    const float* mu = a.in[7];
    const int half = gw & 1, c = half * 256 + 4 * lane, h = c >> 6;
    const f32x4 mur = *(const f32x4*)(mu + c), muk = *(const f32x4*)(mu + 512 + c), kkw = *(const f32x4*)(a.in[13] + c), kaw = *(const f32x4*)(a.in[14] + c), rkw = *(const f32x4*)(a.in[15] + c), a0w = *(const f32x4*)(a.in[10] + c), w0w = *(const f32x4*)(a.in[8] + c);
    const int MS = NGW >> 1;
    for (int mb = gw >> 1; mb < T; mb += 4 * MS) {
        u32x2 zr[4], zk[4], zrp[4], zkp[4], za[4];
#pragma unroll
        for (int i = 0; i < 4; ++i) {
            const int m = mb + i * MS; const bool ok = m < T; const int mm = ok ? m : 0, s = mm & (SEQ - 1);
            const bf16* zp = Z + (size_t)mm * ZW + c;
            zr[i] = *(const u32x2*)zp; zk[i] = *(const u32x2*)(zp + 512); za[i] = *(const u32x2*)(Aa + (size_t)mm * 512 + c);
            const bf16* zq = s ? zp - ZW : zp;
            zrp[i] = *(const u32x2*)zq; zkp[i] = *(const u32x2*)(zq + 512);
            if (!s) { zrp[i] = (u32x2){0u, 0u}; zkp[i] = zrp[i]; }
        }
#pragma unroll
        for (int i = 0; i < 4; ++i) {
            const int m = mb + i * MS; if (m >= T) break;
            const f32x4 rc = bf4(zr[i]), kc = bf4(zk[i]), rp = bf4(zrp[i]), kp = bf4(zkp[i]), av = bf4(za[i]);
            const f32x4 r = rc + (rp - rc) * mur, k = kc + (kp - kc) * muk;
            const f32x4 kr = k * kkw;
            const float ss = red16((kr.x * kr.x + kr.y * kr.y) + (kr.z * kr.z + kr.w * kr.w));
            const float inv = 1.0f / fmaxf(sqrtf(ss), 1e-12f);
            const f32x4 kt = k * (1.0f + (av - 1.0f) * kaw);
            const f32x4 bb = r * kt * rkw;
            const float bon = red16((bb.x + bb.y) + (bb.z + bb.w));
            *(u32x2*)(KK + (size_t)m * 512 + c) = pk4(kr * inv);
            if ((lane & 15) == 0) BON[m * 8 + h] = bon;
        }
    }
}

constexpr int SCH = 32, SROW = 336;
__device__ __forceinline__ void scan_phase(const Args& a, LAS unsigned char* lds, const bf16* Z, const float* W, const bf16* Aa, const bf16* KK, float* Y, int tid, int lane, int wave) {
    const float* mu = a.in[7];
    LAS float* buf = (LAS float*)lds;
    const int lt = tid & 255, step0 = lt >> 4, seg = lt & 15;
    const bool loader = wave >= 4;
    for (int u = blockIdx.x; u < 256; u += gridDim.x) {
        const int bh = (u & 7) + 8 * (u >> 5), rg = (u >> 3) & 3, b = bh >> 3, h = bh & 7;
        const int c = h * 64 + 4 * seg;
        const int cv = h * 64 + rg * 16 + 4 * (seg & 3);
        const f32x4 mur = *(const f32x4*)(mu + c), muk = *(const f32x4*)(mu + 512 + c), muv = *(const f32x4*)(mu + 1024 + cv), kaw = *(const f32x4*)(a.in[14] + c);
        const size_t m0 = (size_t)b * SEQ;
        u32x2 zr[2], zrp[2], zk[2], zkp[2], zv[2], zvp[2], kk4[2], a4[2]; f32x4 w4[2];
#pragma unroll
        for (int i = 0; i < 2; ++i) { zv[i] = (u32x2){0u, 0u}; zvp[i] = zv[i]; }
#define SCAN_LOAD1(t0, i) do { const int t_ = (t0) + step0 + 16 * (i); const size_t m_ = m0 + t_; const bf16* zp_ = Z + m_ * ZW; \
            zr[i] = *(const u32x2*)(zp_ + c); zk[i] = *(const u32x2*)(zp_ + 512 + c); if (seg < 4) zv[i] = *(const u32x2*)(zp_ + 1024 + cv); \
            if (t_ > 0) { zrp[i] = *(const u32x2*)(zp_ - ZW + c); zkp[i] = *(const u32x2*)(zp_ - ZW + 512 + c); if (seg < 4) zvp[i] = *(const u32x2*)(zp_ - ZW + 1024 + cv); } \
            else { zrp[i] = (u32x2){0u, 0u}; zkp[i] = zrp[i]; zvp[i] = zrp[i]; } \
            kk4[i] = *(const u32x2*)(KK + m_ * 512 + c); a4[i] = *(const u32x2*)(Aa + m_ * 512 + c); w4[i] = *(const f32x4*)(W + m_ * 512 + c); } while (0)
#define SCAN_STORE1(bi, i) do { LAS float* d_ = buf + (bi) * (SCH * SROW) + (step0 + 16 * (i)) * SROW + 4 * seg; \
            const f32x4 rc_ = bf4(zr[i]), rp_ = bf4(zrp[i]), kc_ = bf4(zk[i]), kp_ = bf4(zkp[i]), av_ = bf4(a4[i]), kkv_ = bf4(kk4[i]), wd_ = w4[i]; \
            const f32x4 r_ = rc_ + (rp_ - rc_) * mur, k_ = kc_ + (kp_ - kc_) * muk; \
            *(LAS f32x4*)(d_) = wd_; *(LAS f32x4*)(d_ + 64) = k_ * (1.0f + (av_ - 1.0f) * kaw); *(LAS f32x4*)(d_ + 128) = -kkv_; *(LAS f32x4*)(d_ + 192) = kkv_ * av_; *(LAS f32x4*)(d_ + 256) = r_; \
            if (seg < 4) { const f32x4 vc_ = bf4(zv[i]), vp_ = bf4(zvp[i]); *(LAS f32x4*)(d_ + 320) = vc_ + (vp_ - vc_) * muv; } } while (0)
#define SCAN_LOAD(t0) do { SCAN_LOAD1(t0, 0); SCAN_LOAD1(t0, 1); } while (0)
#define SCAN_STORE(bi) do { SCAN_STORE1(bi, 0); SCAN_STORE1(bi, 1); } while (0)
        if (loader) { SCAN_LOAD(0); SCAN_STORE(0); SCAN_LOAD(SCH); }
        lds_barrier();
        f32x2 S01 = {0.f, 0.f}, S23 = {0.f, 0.f};
        const bool dfirst = (u == (int)blockIdx.x);
        const int NL = gridDim.x * 4, gl = blockIdx.x * 4 + (wave - 4);
        LAS float* dscr = (LAS float*)(lds + 90112 + (wave & 3) * 8448);
        float dtv[32];
#pragma unroll
        for (int i = 0; i < 32; ++i) dtv[i] = 0.f;
        const bool consumer = wave < 4;
        const int j = lane & 15, ri = 4 * wave + (lane >> 4);
        float* yp = Y + m0 * 512 + h * 64 + rg * 16 + ri;
        for (int ch = 0; ch < SEQ / SCH; ++ch) {
            if (loader) {
                if (ch + 1 < SEQ / SCH) SCAN_STORE((ch + 1) & 1);
                if (ch + 2 < SEQ / SCH) SCAN_LOAD((ch + 2) * SCH);
                if (dfirst) {
                    const int dit = gl + (ch >> 3) * NL;
                    if (dit < DEFER_ITEMS) {
                        if ((ch & 7) == 1) { const DeferItem d = defer_decode(a, dit); transpose_load(d.W, d.K, d.N, d.item, lane, dtv); }
                        else if ((ch & 7) == 2) { const DeferItem d = defer_decode(a, dit); transpose_store(d.K, d.N, d.WT, d.mode, dscr, d.item, lane, dtv); }
                    }
                }
            }
            if (consumer) {
                const LAS float* sb = buf + (ch & 1) * (SCH * SROW) + 4 * j;
                const LAS float* vb = buf + (ch & 1) * (SCH * SROW) + 320 + ri;
                f32x4 pw[3], pk[3], pa[3], pb[3], pr[3]; float pv[3];
#pragma unroll
                for (int i = 0; i < 2; ++i) { const LAS float* p = sb + i * SROW;
                    pw[i] = *(const LAS f32x4*)p; pk[i] = *(const LAS f32x4*)(p + 64); pa[i] = *(const LAS f32x4*)(p + 128); pb[i] = *(const LAS f32x4*)(p + 192); pr[i] = *(const LAS f32x4*)(p + 256); pv[i] = vb[i * SROW]; }
                float ykA = 0.f, ykB = 0.f, yd = 0.f;
#pragma unroll
                for (int q = 0; q < SCH; ++q) {
                    const f32x4 wv = pw[q % 3], kv = pk[q % 3], av = pa[q % 3], bv = pb[q % 3], rv = pr[q % 3]; const float vv = pv[q % 3];
                    if (q + 2 < SCH) {
                        const LAS float* p = sb + (q + 2) * SROW; const int i = (q + 2) % 3;
                        pw[i] = *(const LAS f32x4*)p; pk[i] = *(const LAS f32x4*)(p + 64); pa[i] = *(const LAS f32x4*)(p + 128); pb[i] = *(const LAS f32x4*)(p + 192); pr[i] = *(const LAS f32x4*)(p + 256);
                        pv[i] = vb[(q + 2) * SROW];
                    }
                    f32x2 t2 = S01 * (f32x2){av.x, av.y}; t2 = S23 * (f32x2){av.z, av.w} + t2;
                    float sa = t2.x + t2.y;
                    sa += dppf<0xB1>(sa); yd += dppf<0xB1>(yd);
                    sa += dppf<0x4E>(sa); yd += dppf<0x4E>(yd);
                    sa += dppf<0x141>(sa); yd += dppf<0x141>(yd);
                    sa += dppf<0x140>(sa); yd += dppf<0x140>(yd);
                    if (q > 0) { if (q <= 16) ykA = (j == q - 1) ? yd : ykA; else ykB = (j == q - 17) ? yd : ykB; }
                    const f32x2 u01 = S01 * (f32x2){wv.x, wv.y} + (f32x2){kv.x, kv.y} * vv, u23 = S23 * (f32x2){wv.z, wv.w} + (f32x2){kv.z, kv.w} * vv;
                    S01 = u01 + (f32x2){bv.x, bv.y} * sa; S23 = u23 + (f32x2){bv.z, bv.w} * sa;
                    f32x2 y2 = S01 * (f32x2){rv.x, rv.y}; y2 = S23 * (f32x2){rv.z, rv.w} + y2;
                    yd = y2.x + y2.y;
                }
                yd = red16(yd); ykB = (j == 15) ? yd : ykB;
                yp[(size_t)(ch * SCH + j) * 512] = ykA;
                yp[(size_t)(ch * SCH + 16 + j) * 512] = ykB;
            }
            lds_barrier();
        }
        if (loader && dfirst) {
            for (int dit = gl + (SEQ / SCH / 8) * NL; dit < DEFER_ITEMS; dit += NL) { const DeferItem d = defer_decode(a, dit); transpose_load(d.W, d.K, d.N, d.item, lane, dtv); transpose_store(d.K, d.N, d.WT, d.mode, dscr, d.item, lane, dtv); }
        }
#undef SCAN_LOAD
#undef SCAN_STORE
#undef SCAN_LOAD1
#undef SCAN_STORE1
    }
}

__device__ __forceinline__ void e3_phase(const Args& a, LAS unsigned char* lds, const bf16* Z, const float* Y, const float* BON, const bf16* G, bf16* YC, int tid, int lane, int wave) {
    const int gw = blockIdx.x * NWAVES + wave, NGW = gridDim.x * NWAVES;
    {
        const int half = gw & 1, c = half * 256 + 4 * lane, h = c >> 6;
        const f32x4 muv = *(const f32x4*)(a.in[7] + 1024 + c), lw = *(const f32x4*)(a.in[16] + c), lb = *(const f32x4*)(a.in[17] + c);
        const int MS = NGW >> 1;
        for (int mb = gw >> 1; mb < T; mb += 4 * MS) {
            f32x4 yv[4]; u32x2 zv[4], zvp[4], gv[4]; float bn[4];
#pragma unroll
            for (int i = 0; i < 4; ++i) {
                const int m = mb + i * MS; const bool ok = m < T; const int mm = ok ? m : 0, s = mm & (SEQ - 1);
                yv[i] = *(const f32x4*)(Y + (size_t)mm * 512 + c);
                const bf16* zp = Z + (size_t)mm * ZW + 1024 + c;
                zv[i] = *(const u32x2*)zp; zvp[i] = *(const u32x2*)(s ? zp - ZW : zp); if (!s) zvp[i] = (u32x2){0u, 0u};
                gv[i] = *(const u32x2*)(G + (size_t)mm * 512 + c); bn[i] = BON[mm * 8 + h];
            }
#pragma unroll
            for (int i = 0; i < 4; ++i) {
                const int m = mb + i * MS; if (m >= T) break;
                const f32x4 y = yv[i], vc = bf4(zv[i]), vp = bf4(zvp[i]), g = bf4(gv[i]);
                const float mean = red16((y.x + y.y) + (y.z + y.w)) * (1.f / 64.f);
                const f32x4 d = y - mean;
                const float var = red16((d.x * d.x + d.y * d.y) + (d.z * d.z + d.w * d.w)) * (1.f / 64.f);
                const f32x4 yn = d * rsqrtf(var + 64e-5f) * lw + lb;
                const f32x4 v = vc + (vp - vc) * muv;
                *(u32x2*)(YC + (size_t)m * DM + c) = pk4((yn + v * bn[i]) * g);
            }
        }
    }
    {
        LAS float* gl = (LAS float*)lds;
        const int ch = tid;
        const int sr = tid >> 6, sseg = tid & 63;
        f32x4 gb1a = *(const f32x4*)(a.in[18] + 8 * sseg), gb1b = *(const f32x4*)(a.in[18] + 8 * sseg + 4), gb2a = *(const f32x4*)(a.in[18] + 512 + 8 * sseg), gb2b = *(const f32x4*)(a.in[18] + 512 + 8 * sseg + 4);
        const float dwb = a.in[20][ch];
        float dw[31];
#pragma unroll
        for (int j = 0; j < 31; ++j) dw[j] = a.in[19][j * 512 + ch];
        const f32x4 cw0 = *(const f32x4*)(a.in[21] + 4 * lane), cw1 = *(const f32x4*)(a.in[21] + 256 + 4 * lane), cb0 = *(const f32x4*)(a.in[22] + 4 * lane), cb1 = *(const f32x4*)(a.in[22] + 256 + 4 * lane);
        for (int tile = blockIdx.x; tile < T / 32; tile += gridDim.x) {
            const int m0 = tile * 32, s0 = m0 & (SEQ - 1);
            u32x4 r1[8], r2[8];
#pragma unroll
            for (int i = 0; i < 8; ++i) {
                const int tt = 8 * i + sr, s = s0 - 30 + tt; const bool ok = tt < 62 && s >= 0;
                const bf16* zp = Z + (size_t)(ok ? m0 - 30 + tt : m0) * ZW + 1792 + 8 * sseg;
                r1[i] = *(const u32x4*)zp; r2[i] = *(const u32x4*)(zp + 512);
            }
#pragma unroll
            for (int i = 0; i < 8; ++i) {
                const int tt = 8 * i + sr, s = s0 - 30 + tt;
                if (tt < 62) {
                    f32x4 o0, o1;
                    if (s >= 0) {
                        const f32x4 u1a = (f32x4){bflo(r1[i].x), bfhi(r1[i].x), bflo(r1[i].y), bfhi(r1[i].y)} + gb1a, u1b = (f32x4){bflo(r1[i].z), bfhi(r1[i].z), bflo(r1[i].w), bfhi(r1[i].w)} + gb1b;
                        const f32x4 u2a = (f32x4){bflo(r2[i].x), bfhi(r2[i].x), bflo(r2[i].y), bfhi(r2[i].y)} + gb2a, u2b = (f32x4){bflo(r2[i].z), bfhi(r2[i].z), bflo(r2[i].w), bfhi(r2[i].w)} + gb2b;
                        o0 = (f32x4){u1a.x * fsigmoid(u2a.x), u1a.y * fsigmoid(u2a.y), u1a.z * fsigmoid(u2a.z), u1a.w * fsigmoid(u2a.w)};
                        o1 = (f32x4){u1b.x * fsigmoid(u2b.x), u1b.y * fsigmoid(u2b.y), u1b.z * fsigmoid(u2b.z), u1b.w * fsigmoid(u2b.w)};
                    } else { o0 = (f32x4){0.f, 0.f, 0.f, 0.f}; o1 = o0; }
                    *(LAS f32x4*)(gl + tt * 512 + 8 * sseg) = o0; *(LAS f32x4*)(gl + tt * 512 + 8 * sseg + 4) = o1;
                }
            }
            __syncthreads();
            {
                float gv[62];
#pragma unroll
                for (int i = 0; i < 62; ++i) gv[i] = gl[i * 512 + ch];
#pragma unroll
                for (int t = 0; t < 32; ++t) {
                    float acc = dwb;
#pragma unroll
                    for (int j = 0; j < 31; ++j) acc += gv[t + j] * dw[j];
                    gl[t * 512 + ch] = acc;
                }
            }
            __syncthreads();
#pragma unroll
            for (int q = 0; q < 4; ++q) {
                const int t = 4 * wave + q;
                const f32x4 x0 = *(const LAS f32x4*)(gl + t * 512 + 4 * lane), x1 = *(const LAS f32x4*)(gl + t * 512 + 256 + 4 * lane);
                const float mean = wave_sum((x0.x + x0.y) + (x0.z + x0.w) + (x1.x + x1.y) + (x1.z + x1.w)) * (1.f / 512.f);
                const f32x4 d0 = x0 - mean, d1 = x1 - mean;
                const float var = wave_sum((d0.x * d0.x + d0.y * d0.y) + (d0.z * d0.z + d0.w * d0.w) + (d1.x * d1.x + d1.y * d1.y) + (d1.z * d1.z + d1.w * d1.w)) * (1.f / 512.f);
                const float rs = rsqrtf(var + 1e-5f);
                f32x4 y0 = d0 * rs * cw0 + cb0, y1 = d1 * rs * cw1 + cb1;
                y0.x *= fsigmoid(y0.x); y0.y *= fsigmoid(y0.y); y0.z *= fsigmoid(y0.z); y0.w *= fsigmoid(y0.w);
                y1.x *= fsigmoid(y1.x); y1.y *= fsigmoid(y1.y); y1.z *= fsigmoid(y1.z); y1.w *= fsigmoid(y1.w);
                bf16* o = YC + (size_t)(m0 + t) * DM + 512 + 4 * lane;
                *(u32x2*)o = pk4(y0); *(u32x2*)(o + 256) = pk4(y1);
            }
            __syncthreads();
        }
    }
}

__device__ __forceinline__ void qkrope_phase(const Args& a, LAS unsigned char* lds, const bf16* Z3, bf16* Qn, bf16* Kn, bf16* Vt, int tid, int lane, int wave) {
    const int gw = blockIdx.x * NWAVES + wave, NGW = gridDim.x * NWAVES;
    const float* COS = (const float*)(a.ws + WS_ROPE); const float* SIN = COS + SEQ * 32;
    {
        const int part = gw & 3, isk = part >> 1, grp = lane >> 3, j = lane & 7, gi = (part & 1) * 8 + grp, h = gi >> 1, c = gi & 1;
        const int col0 = isk * 1024 + gi * 64 + 4 * j;
        const float* nw = a.in[isk ? 26 : 25];
        const f32x4 n1 = *(const f32x4*)(nw + 4 * j), n2 = *(const f32x4*)(nw + 32 + 4 * j);
        const float sc = isk ? 1.0f : QSCALE;
        bf16* dstb = isk ? Kn : Qn;
        const int MS = NGW >> 2;
        for (int mb = gw >> 2; mb < T; mb += 4 * MS) {
            u32x2 z1[4], z2[4]; f32x4 csv[4], snv[4];
#pragma unroll
            for (int i = 0; i < 4; ++i) {
                const int m = mb + i * MS; const int mm = m < T ? m : 0, s = mm & (SEQ - 1);
                const bf16* zp = Z3 + (size_t)mm * Z3W + col0;
                z1[i] = *(const u32x2*)zp; z2[i] = *(const u32x2*)(zp + 32);
                csv[i] = *(const f32x4*)(COS + s * 32 + 4 * j); snv[i] = *(const f32x4*)(SIN + s * 32 + 4 * j);
            }
#pragma unroll
            for (int i = 0; i < 4; ++i) {
                const int m = mb + i * MS; if (m >= T) break;
                const int b = m >> 12, s = m & (SEQ - 1);
                f32x4 x1 = bf4(z1[i]), x2 = bf4(z2[i]);
                const float ss = red8((x1.x * x1.x + x1.y * x1.y) + (x1.z * x1.z + x1.w * x1.w) + (x2.x * x2.x + x2.y * x2.y) + (x2.z * x2.z + x2.w * x2.w));
                const float rs = rsqrtf(ss * (1.f / 64.f) + 1e-6f);
                x1 = x1 * rs * n1; x2 = x2 * rs * n2;
                const f32x4 o1 = (x1 * csv[i] - x2 * snv[i]) * sc, o2 = (x2 * csv[i] + x1 * snv[i]) * sc;
                bf16* d = dstb + ((size_t)(((b * 8 + h) * 2 + c)) * SEQ + s) * 64 + 4 * j;
                *(u32x2*)d = pk4(o1); *(u32x2*)(d + 32) = pk4(o2);
            }
        }
    }
    {
        LAS bf16* Vs = (LAS bf16*)lds;
        for (int it = blockIdx.x; it < 64 * 64; it += gridDim.x) {
            const int bh = it >> 6, tile = it & 63, b = bh >> 3, h = bh & 7;
            { const int tk = tid >> 3, seg = tid & 7;
              const bf16* src = Z3 + (size_t)(b * SEQ + 64 * tile + tk) * Z3W + 2048 + h * 128 + 16 * seg;
              const u32x4 v0 = *(const u32x4*)src, v1 = *(const u32x4*)(src + 8);
              *(LAS u32x4*)(Vs + tk * 136 + 16 * seg) = v0; *(LAS u32x4*)(Vs + tk * 136 + 16 * seg + 8) = v1; }
            __syncthreads();
            { const int dv = tid >> 2, qr = tid & 3; unsigned w[8];
#pragma unroll
              for (int p = 0; p < 16; p += 2) {
                  const int k0 = 16 * qr + 4 * (p >> 3) + (p & 3) + 8 * ((p & 7) >> 2), k1 = k0 + 1;
                  w[p >> 1] = (unsigned)Vs[k0 * 136 + dv] | ((unsigned)Vs[k1 * 136 + dv] << 16);
              }
              bf16* dst = Vt + ((size_t)bh * 128 + dv) * SEQ + 64 * tile + 16 * qr;
              *(u32x4*)dst = (u32x4){w[0], w[1], w[2], w[3]}; *(u32x4*)(dst + 8) = (u32x4){w[4], w[5], w[6], w[7]}; }
            __syncthreads();
        }
    }
}

constexpr int AT_KB = 9216, AT_VB = 18432, AT_BUF = AT_KB + AT_VB;
__device__ __forceinline__ void attn_phase(const Args& a, LAS unsigned char* lds, const bf16* Qn, const bf16* Kn, const bf16* Vt, bf16* O, float* stash, int tid, int lane, int wave) {
    const int n32 = lane & 31, hi = lane >> 5;
    const float lam = *(const float*)(a.ws + WS_LAM);
    const float* subn = a.in[31];
    if (wave < 4) __builtin_amdgcn_s_setprio(2);
    for (int u = blockIdx.x; u < 1024; u += gridDim.x) {
        const int ub = u & 255, bh = (ub & 7) + 8 * (ub >> 5), quad = (ub >> 3) & 3, rnd = u >> 8;
        const int qb = rnd == 0 ? quad : (rnd == 1 ? 7 - quad : (rnd == 2 ? 8 + quad : 15 - quad));
        const int b = bh >> 3, h = bh & 7;
        const int NT = 4 * qb + 4, td = 4 * qb + (wave >> 1);
        const int qloc = 32 * (wave & 1) + n32;
        for (int c = 0; c < 2; ++c) {
            const bf16* Qp = Qn + ((size_t)(bh * 2 + c) * SEQ + 256 * qb + 32 * wave + n32) * 64 + 8 * hi;
            bf16x8 qf[4];
#pragma unroll
            for (int ds = 0; ds < 4; ++ds) qf[ds] = *(const bf16x8*)(Qp + 16 * ds);
            const bf16* Kp = Kn + (size_t)(bh * 2 + c) * SEQ * 64 + tid * 8;
            const bf16* Vp = Vt + (size_t)bh * 128 * SEQ + (size_t)(tid >> 3) * SEQ + 8 * (tid & 7);
            const int kofs = (tid >> 3) * 144 + (tid & 7) * 16;
            f32x16 o[4];
#pragma unroll
            for (int i = 0; i < 4; ++i)
#pragma unroll
                for (int r = 0; r < 16; ++r) o[i][r] = 0.f;
            float mrun = -INFINITY, lsum = 0.f;
            u32x4 kreg[2], vreg0[2], vreg1[2];
            kreg[0] = gload16_asm(Kp); vreg0[0] = gload16_asm(Vp); vreg1[0] = gload16_asm(Vp + (size_t)64 * SEQ);
            kreg[1] = gload16_asm(Kp + 4096); vreg0[1] = gload16_asm(Vp + 64); vreg1[1] = gload16_asm(Vp + (size_t)64 * SEQ + 64);
            asm volatile("" :: "v"(qf[0]), "v"(qf[1]), "v"(qf[2]), "v"(qf[3]));
            asm volatile("s_waitcnt vmcnt(3)" ::: "memory");
            *(LAS u32x4*)(lds + kofs) = kreg[0]; *(LAS u32x4*)(lds + AT_KB + kofs) = vreg0[0]; *(LAS u32x4*)(lds + AT_KB + 64 * 144 + kofs) = vreg1[0];
            lds_barrier();
            for (int tp = 0; tp < NT; tp += 2) {
#pragma unroll
              for (int hh = 0; hh < 2; ++hh) {
                const int t = tp + hh;
                if (t + 2 < NT) { kreg[hh] = gload16_asm(Kp + (size_t)(t + 2) * 4096); vreg0[hh] = gload16_asm(Vp + 64 * (t + 2)); vreg1[hh] = gload16_asm(Vp + (size_t)64 * SEQ + 64 * (t + 2)); }
                if (t <= td) {
                    const LAS unsigned char* kb = lds + (t & 1) * AT_BUF + n32 * 144 + hi * 16;
                    f32x16 p0, p1;
#pragma unroll
                    for (int r = 0; r < 16; ++r) { p0[r] = 0.f; p1[r] = 0.f; }
                    bf16x8 kf0[4], kf1[4];
#pragma unroll
                    for (int ds = 0; ds < 4; ++ds) { kf0[ds] = *(const LAS bf16x8*)(kb + ds * 32); kf1[ds] = *(const LAS bf16x8*)(kb + 32 * 144 + ds * 32); }
                    const LAS unsigned char* vb = lds + (t & 1) * AT_BUF + AT_KB + n32 * 144 + hi * 16;
                    bf16x8 vf[2][4];
#pragma unroll
                    for (int i = 0; i < 4; ++i) vf[0][i] = *(const LAS bf16x8*)(vb + i * 32 * 144);
                    __builtin_amdgcn_sched_barrier(0);
                    #pragma unroll
                    for (int ds = 0; ds < 4; ++ds) {
                        p0 = __builtin_amdgcn_mfma_f32_32x32x16_bf16(kf0[ds], qf[ds], p0, 0, 0, 0);
                        p1 = __builtin_amdgcn_mfma_f32_32x32x16_bf16(kf1[ds], qf[ds], p1, 0, 0, 0);
                    }
                                        __builtin_amdgcn_sched_barrier(0);
                    if (t == td) {
                        asm volatile("" ::: "memory");
#pragma unroll
                        for (int r = 0; r < 16; ++r) { const int key = (r & 3) + 8 * (r >> 2) + 4 * hi; if (key > qloc) p0[r] = -INFINITY; if (key + 32 > qloc) p1[r] = -INFINITY; }
                    }
                    asm volatile("s_nop 15\n\ts_nop 7" : "+v"(p0), "+v"(p1));
                    float mx, mxb;
                    mx = max3f(p0[0], p0[1], p1[0]); mxb = max3f(p0[2], p0[3], p1[1]); mx = max3f(mx, p1[2], p1[3]);
#pragma unroll
                    for (int r = 4; r < 16; r += 4) { mx = max3f(mx, p0[r], p0[r + 1]); mxb = max3f(mxb, p0[r + 2], p0[r + 3]); mx = max3f(mx, p1[r], p1[r + 1]); mxb = max3f(mxb, p1[r + 2], p1[r + 3]); }
                    mx = max3f(mx, mxb, mxb);
                    { auto rr = __builtin_amdgcn_permlane32_swap(__float_as_uint(mx), __float_as_uint(mx), false, false); mx = max3f(__uint_as_float(rr[0]), __uint_as_float(rr[1]), mrun); }
                    const float mnew = mx;
                    if (__builtin_amdgcn_ballot_w64(mnew > mrun + 8.0f)) {
                        const float alpha = __builtin_amdgcn_exp2f(mrun - mnew);
                        lsum *= alpha;
#pragma unroll
                        for (int i = 0; i < 4; ++i) o[i] = o[i] * alpha;
                        mrun = mnew;
                    }
                    {
                        const f32x2 mm2 = {mrun, mrun};
#pragma unroll
                        for (int r = 0; r < 16; r += 2) { const f32x2 a2 = (f32x2){p0[r], p0[r + 1]} - mm2, b2 = (f32x2){p1[r], p1[r + 1]} - mm2; p0[r] = a2.x; p0[r + 1] = a2.y; p1[r] = b2.x; p1[r + 1] = b2.y; }
                    }
#pragma unroll
                    for (int r = 0; r < 16; ++r) { p0[r] = __builtin_amdgcn_exp2f(p0[r]); p1[r] = __builtin_amdgcn_exp2f(p1[r]); }
                    {
                        const f32x16 ps = p0 + p1;
                        f32x2 s2 = (f32x2){ps[0], ps[1]} + (f32x2){ps[2], ps[3]};
#pragma unroll
                        for (int r = 4; r < 16; r += 2) s2 += (f32x2){ps[r], ps[r + 1]};
                        lsum += s2.x + s2.y;
                    }
                    bf16x8 pf[4];
#pragma unroll
                    for (int s4 = 0; s4 < 4; ++s4) {
                        u32x4 w;
                        if (s4 < 2) { w.x = pk2(p0[8 * s4 + 0], p0[8 * s4 + 1]); w.y = pk2(p0[8 * s4 + 2], p0[8 * s4 + 3]); w.z = pk2(p0[8 * s4 + 4], p0[8 * s4 + 5]); w.w = pk2(p0[8 * s4 + 6], p0[8 * s4 + 7]); }
                        else { const int q = s4 - 2; w.x = pk2(p1[8 * q + 0], p1[8 * q + 1]); w.y = pk2(p1[8 * q + 2], p1[8 * q + 3]); w.z = pk2(p1[8 * q + 4], p1[8 * q + 5]); w.w = pk2(p1[8 * q + 6], p1[8 * q + 7]); }
                        pf[s4] = __builtin_bit_cast(bf16x8, w);
                    }
#pragma unroll
                    for (int s4 = 0; s4 < 4; ++s4) {
                        if (s4 + 1 < 4) {
#pragma unroll
                            for (int i = 0; i < 4; ++i) vf[(s4 + 1) & 1][i] = *(const LAS bf16x8*)(vb + i * 32 * 144 + (s4 + 1) * 32);
                        }
                        __builtin_amdgcn_sched_barrier(0);
                        #pragma unroll
                        for (int i = 0; i < 4; ++i) o[i] = __builtin_amdgcn_mfma_f32_32x32x16_bf16(vf[s4 & 1][i], pf[s4], o[i], 0, 0, 0);
                                                __builtin_amdgcn_sched_barrier(0);
                    }
                }
                if (t + 1 < NT) { if (t + 2 < NT) asm volatile("s_waitcnt vmcnt(3)" ::: "memory"); else asm volatile("s_waitcnt vmcnt(0)" ::: "memory");
                    LAS unsigned char* d = lds + ((t + 1) & 1) * AT_BUF; *(LAS u32x4*)(d + kofs) = kreg[hh ^ 1]; *(LAS u32x4*)(d + AT_KB + kofs) = vreg0[hh ^ 1]; *(LAS u32x4*)(d + AT_KB + 64 * 144 + kofs) = vreg1[hh ^ 1]; }
                lds_barrier();
              }
            }
            const float inv = 1.0f / xhalf_sum(lsum);
            int oz; asm volatile("v_mov_b32 %0, 0" : "=v"(oz));
            float* st = stash + ((size_t)blockIdx.x * 8 + wave) * 4096 + lane + oz;
            if (c == 0) {
#pragma unroll
                for (int i = 0; i < 4; ++i)
#pragma unroll
                    for (int r = 0; r < 16; ++r) __builtin_nontemporal_store(o[i][r] * inv, &st[(i * 16 + r) * 64]);
            } else {
                float ss = 0.f;
#pragma unroll
                for (int i = 0; i < 4; ++i) {
                    float tv[16];
#pragma unroll
                    for (int r = 0; r < 16; ++r) tv[r] = __builtin_nontemporal_load(&st[(i * 16 + r) * 64]);
                    asm volatile("" ::: "memory");
#pragma unroll
                    for (int r = 0; r < 16; ++r) { const float v = tv[r] - lam * (o[i][r] * inv); o[i][r] = v; ss += v * v; }
                }
                ss = xhalf_sum(ss);
                const float rs = rsqrtf(ss * (1.f / 128.f) + 1e-5f) * (1.0f - LAM_INIT);
                bf16* op = O + (size_t)(b * SEQ + 256 * qb + 32 * wave + n32 + oz) * DM + h * 128 + 4 * hi;
#pragma unroll
                for (int i = 0; i < 4; ++i)
#pragma unroll
                    for (int r4 = 0; r4 < 4; ++r4) {
                        const f32x4 sn = *(const f32x4*)(subn + 32 * i + 8 * r4 + 4 * hi);
                        const f32x4 v = (f32x4){o[i][4 * r4], o[i][4 * r4 + 1], o[i][4 * r4 + 2], o[i][4 * r4 + 3]} * rs * sn;
                        *(u32x2*)(op + 32 * i + 8 * r4) = pk4(v);
                    }
            }
        }
    }
    __builtin_amdgcn_s_setprio(0);
}

#define XB_TMO      128
#define XB_XCNT(j)  (256  + 64 * (j))
#define XB_XSUB(j)  (1280 + 64 * (j))
#define XB_XGEN(j)  (2304 + 64 * (j))
#define XB_TOP      3328
#define XB_TOPGEN   3392
#define XCD_BAR_WORDS 3456
#define XB_SPIN_CAP (1u << 18)

__device__ __forceinline__ unsigned xb_ld(unsigned* p)              { return __hip_atomic_load(p, __ATOMIC_RELAXED, __HIP_MEMORY_SCOPE_AGENT); }
__device__ __forceinline__ unsigned xb_add(unsigned* p, unsigned v) { return __hip_atomic_fetch_add(p, v, __ATOMIC_RELAXED, __HIP_MEMORY_SCOPE_AGENT); }
__device__ __forceinline__ unsigned xb_xcc_id() { return (unsigned)__builtin_amdgcn_s_getreg((3 << 11) | 20) & 0xFu; }
#define XB_SPIN(cond, bar) do { unsigned _sp = 0; while (cond) { __builtin_amdgcn_s_sleep(1); \
    if ((++_sp & 255u) == 0u) { if (xb_ld(&(bar)[XB_TMO])) break; if (_sp > XB_SPIN_CAP) { atomicAdd(&(bar)[XB_TMO], 1u); break; } } } } while (0)

struct XcdBarrier {
    unsigned* bar; unsigned x;
    volatile LAS unsigned* st;
};

__device__ __forceinline__ XcdBarrier xcd_barrier_post(unsigned* bar, volatile LAS unsigned* st) {
    XcdBarrier b; b.bar = bar; b.x = xb_xcc_id(); b.st = st;
    if (threadIdx.x == 0) (void)xb_add(&bar[XB_XCNT(b.x)], 1u);
    return b;
}
__device__ __forceinline__ void xcd_barrier_complete(unsigned* bar, unsigned x, unsigned& nloc, unsigned& nx) {
    const unsigned G = gridDim.x * gridDim.y * gridDim.z;
    unsigned sum, cnt, mine, sp = 0u;
    for (;;) {
        sum = 0u; cnt = 0u; mine = 0u;
#pragma unroll
        for (unsigned j = 0; j < 16; ++j) { const unsigned c = xb_ld(&bar[XB_XCNT(j)]); sum += c; cnt += (c > 0u) ? 1u : 0u; mine = (j == x) ? c : mine; }
        if (sum == G) break;
        __builtin_amdgcn_s_sleep(1);
        if ((++sp & 255u) == 0u) { if (xb_ld(&bar[XB_TMO])) break; if (sp > XB_SPIN_CAP) { atomicAdd(&bar[XB_TMO], 1u); break; } }
    }
    nloc = mine > 0u ? mine : 1u; nx = cnt > 0u ? cnt : 1u;
}

__device__ __forceinline__ void xcd_barrier(const XcdBarrier& b) {
    asm volatile("s_waitcnt vmcnt(0)" ::: "memory");
    __syncthreads();
    if (threadIdx.x == 0) {
        unsigned* bar = b.bar;
        __builtin_amdgcn_s_waitcnt(0);
        unsigned nloc = b.st[0], nx = b.st[1];
        if (nloc == 0u) { xcd_barrier_complete(bar, b.x, nloc, nx); b.st[0] = nloc; b.st[1] = nx; }
        const unsigned old = xb_add(&bar[XB_XSUB(b.x)], 1u);
        const unsigned gen = old / nloc;
        if (old + 1u == (gen + 1u) * nloc) {
            __builtin_amdgcn_fence(__ATOMIC_RELEASE, "agent");
            asm volatile("s_waitcnt vmcnt(0)" ::: "memory");
            const unsigned og = xb_add(&bar[XB_TOP], 1u);
            const unsigned tg = og / nx;
            if (og + 1u == (tg + 1u) * nx) xb_add(&bar[XB_TOPGEN], 1u);
            else XB_SPIN(xb_ld(&bar[XB_TOPGEN]) == tg, bar);
            __builtin_amdgcn_fence(__ATOMIC_ACQUIRE, "agent");
            xb_add(&bar[XB_XGEN(b.x)], 1u);
            asm volatile("s_waitcnt vmcnt(0)" ::: "memory");
        } else {
            XB_SPIN(xb_ld(&bar[XB_XGEN(b.x)]) == gen, bar);
            __builtin_amdgcn_fence(__ATOMIC_ACQUIRE, "agent");
            asm volatile("s_waitcnt vmcnt(0)" ::: "memory");
        }
    }
    __syncthreads();
}

#ifndef KMASK
#define KMASK 0xffff
#endif
#define KON(k) ((KMASK >> (k)) & 1)
constexpr int N_PHASES = 20;
__global__ void __launch_bounds__(NTHR, 2) mega_fwd(Args a) {
    extern __shared__ __attribute__((aligned(16))) unsigned char lds_raw[];
    LAS unsigned char* lds = (LAS unsigned char*)lds_raw;
    cg::grid_group grid = cg::this_grid();
    volatile LAS unsigned* bst = (volatile LAS unsigned*)(lds + 131072);
    if (threadIdx.x < 2) bst[threadIdx.x] = 0u;
    __syncthreads();
    const XcdBarrier xbar = xcd_barrier_post((unsigned*)(a.ws + WS_BAR), bst);
#ifndef KREP
#define KREP 0
#endif
    int rep = 0; (void)rep;
    for (int ph = a.ph_lo; ph < a.ph_hi; ++ph) {
        int oz; asm volatile("s_mov_b32 %0, 0" : "=s"(oz));
        const int tid = threadIdx.x + oz, lane = tid & 63, wave = __builtin_amdgcn_readfirstlane(tid >> 6);
        const int gw = blockIdx.x * NWAVES + wave, NGW = gridDim.x * NWAVES;
        unsigned char* ws = a.ws + oz;
        bf16* XN = (bf16*)(ws + WS_XN);
        bf16* BIG = (bf16*)(ws + WS_BIG);
        float* X = a.out + oz;
        int kind = 0, idx = 0;
        switch (ph) {
            case 0: kind = 0; break;
            case 1: kind = 1; idx = 0; break;
            case 2: kind = 2; idx = 0; break;
            case 3: kind = 4; idx = 0; break;
            case 4: kind = 5; break;
            case 5: kind = 6; break;
            case 6: kind = 7; break;
            case 7: kind = 8; break;
            case 8: kind = 9; break;
            case 9: kind = 10; idx = 0; break;
            case 10: kind = 1; idx = 1; break;
            case 11: kind = 2; idx = 1; break;
            case 12: kind = 1; idx = 2; break;
            case 13: kind = 2; idx = 2; break;
            case 14: kind = 4; idx = 1; break;
            case 15: kind = 11; break;
            case 16: kind = 12; break;
            case 17: kind = 10; idx = 1; break;
            case 18: kind = 1; idx = 3; break;
            default: kind = 2; idx = 3; break;
        }
        float* RSQ = (float*)(ws + WS_RSQ);
        if (kind == 0) { if (KON(0))
            prologue_phase(a, lds, tid, lane, wave);
        } else if (kind == 1) { if (KON(1)) {
            EpiSwiGLU E{BIG, ph == 1 ? (const float*)nullptr : (const float*)RSQ};
            run_gemm(lds, XN, (const bf16*)(ws + WS_WGU + idx * WGU_STRIDE), 2 * DFF, DM, E); }
        } else if (kind == 2 || kind == 10) { if (KON(2)) {
            const bool dn = kind == 2;
            const float* gn = ph == 2 ? a.in[5] : (ph == 9 ? a.in[1] + DM : (ph == 11 ? a.in[1] + 2 * DM : (ph == 13 ? a.in[5] + DM : (ph == 17 ? a.in[1] + 3 * DM : (const float*)nullptr))));
            EpiResid E{ph == 2 ? a.in[0] : (const float*)X, X, gn, XN, RSQ, dn ? 0.5f : 1.0f, 0.f};
            const bf16* A = dn ? (const bf16*)BIG : (idx == 0 ? (const bf16*)(ws + WS_R1) : (const bf16*)BIG);
            const bf16* Bt = dn ? (const bf16*)(ws + WS_WD + idx * WD_STRIDE) : (const bf16*)(ws + (idx == 0 ? WS_WEOUT : WS_WCOUT));
            run_gemm(lds, A, Bt, DM, dn ? DFF : DM, E); }
        } else if (kind == 4) { if (KON(4)) {
            EpiStore E{BIG, idx == 0 ? ZW : Z3W, (const float*)RSQ};
            run_gemm(lds, XN, (const bf16*)(ws + (idx == 0 ? WS_WAIN : WS_WCIN)), idx == 0 ? ZW : Z3W, DM, E); }
        } else if (kind == 5) { if (KON(5))
            e1_phase(BIG, a.in[7], (bf16*)(ws + WS_LRIN), tid);
        } else if (kind == 6) { if (KON(6)) {
            EpiLowRank E{(float*)(ws + WS_R1), (bf16*)(ws + WS_R2), (bf16*)(ws + WS_R4), a.in[8], a.in[10]};
            run_gemm(lds, (const bf16*)(ws + WS_LRIN), (const bf16*)(ws + WS_WBD), 1536, 256, E); }
        } else if (kind == 7) { if (KON(7))
            e2_phase(a, BIG, (bf16*)(ws + WS_R2), (float*)(ws + WS_R1), (bf16*)(ws + WS_R3), (float*)(ws + WS_BON), gw, NGW, lane);
        } else if (kind == 8) { if (KON(8))
            scan_phase(a, lds, BIG, (const float*)(ws + WS_R1), (const bf16*)(ws + WS_R2), (const bf16*)(ws + WS_R3), (float*)(ws + WS_XN), tid, lane, wave);
        } else if (kind == 9) { if (KON(9))
            e3_phase(a, lds, BIG, (const float*)(ws + WS_XN), (const float*)(ws + WS_BON), (const bf16*)(ws + WS_R4), (bf16*)(ws + WS_R1), tid, lane, wave);
        } else if (kind == 11) { if (KON(11))
            qkrope_phase(a, lds, BIG, (bf16*)(ws + WS_XN), (bf16*)(ws + WS_R1), (bf16*)(ws + WS_R2), tid, lane, wave);
        } else { if (KON(12))
            attn_phase(a, lds, (const bf16*)(ws + WS_XN), (const bf16*)(ws + WS_R1), (const bf16*)(ws + WS_R2), BIG, (float*)(ws + WS_BIG + 64 * MiB), tid, lane, wave);
        }
#if KREP
        if (!rep && ((KREP >> kind) & 1)) { rep = 1; --ph; } else rep = 0;
#endif
        if (ph + 1 < a.ph_hi) {
            if (ph == a.ph_lo) grid.sync(); else xcd_barrier(xbar);
        }
    }
}

#ifndef MK_PER_PHASE
#define MK_PER_PHASE 0
#endif
extern "C" void kernel_launch(void* const* d_in, const int* in_sizes, int n_in, void* d_out, int out_size, void* d_ws, size_t ws_size, hipStream_t stream) {
    static int grid = 0;
    if (grid == 0) {
        if (n_in != 33 || out_size != T * DM || ws_size < WS_END) { fprintf(stderr, "kernel_launch: unexpected shapes (n_in %d out %d ws %zu)\n", n_in, out_size, ws_size); grid = -1; return; }
        int dev = 0, cus = 0, per_cu = 0;
        hipGetDevice(&dev);
        hipDeviceGetAttribute(&cus, hipDeviceAttributeMultiprocessorCount, dev);
        if (hipFuncSetAttribute((const void*)mega_fwd, hipFuncAttributeMaxDynamicSharedMemorySize, LDS_BYTES) != hipSuccess) { fprintf(stderr, "kernel_launch: hipFuncSetAttribute failed\n"); grid = -1; return; }
        if (hipOccupancyMaxActiveBlocksPerMultiprocessor(&per_cu, (const void*)mega_fwd, NTHR, LDS_BYTES) != hipSuccess || per_cu < 1) { fprintf(stderr, "kernel_launch: occupancy query says %d\n", per_cu); per_cu = 1; }
        (void)hipGetLastError();
        grid = cus * per_cu;
    }
    if (grid < 0) return;
    if (hipMemsetAsync((char*)d_ws + WS_BAR, 0, 16384, stream) != hipSuccess) { fprintf(stderr, "kernel_launch: memset of the barrier words failed\n"); return; }
    Args a{};
    for (int i = 0; i < 33; ++i) a.in[i] = (const float*)d_in[i];
    a.out = (float*)d_out; a.ws = (unsigned char*)d_ws;
#if MK_PER_PHASE
    for (int ph = 0; ph < N_PHASES; ++ph) { a.ph_lo = ph; a.ph_hi = ph + 1; hipLaunchKernelGGL(mega_fwd, dim3(grid), dim3(NTHR), LDS_BYTES, stream, a); }
#else
    a.ph_lo = 0; a.ph_hi = N_PHASES;
    void* kargs[] = {&a};
    hipError_t e = hipLaunchCooperativeKernel((const void*)mega_fwd, dim3(grid), dim3(NTHR), kargs, LDS_BYTES, stream);
    if (e != hipSuccess) fprintf(stderr, "cooperative launch failed: %s (grid %d)\n", hipGetErrorString(e), grid);
#endif
}
```
